# Optimizing an MI355X kernel written in HIP

```python
import math
import jax, jax.numpy as jnp
from jax import lax
import numpy as np

D_MODEL = 1024
BATCH = 8
SEQ = 2048
DEPTH = 4
DEC_BATCH = 128
DEC_SEQ = 8
PAST_LEN = 16384
PAGE_SIZE = 128

N_MIXERS = 2
N_HGRN = (DEPTH + 1) // 2
N_S5 = DEPTH // 2
HG_HEAD_DIM = 128
HG_HEADS = D_MODEL // HG_HEAD_DIM
HG_QK_SCALE = HG_HEAD_DIM ** -0.5
CHUNK = 16
S5_GROUP = 16
S5_GROUPS = D_MODEL // S5_GROUP
S5_STATE = 64
D_FF = -(-8 * D_MODEL // (3 * 256)) * 256
PLE_DIM = 256
ALPHA = (2 * DEPTH) ** 0.25
BETA = (8 * DEPTH) ** -0.25
LN_EPS = 1e-5
RMS_EPS = 1e-6

kernel_name = 'hgrn2_s5_hybrid_decoder_step'


def layer_norm(x, w, b):
    xf = x.astype(jnp.float32)
    mu = jnp.mean(xf, axis=-1, keepdims=True)
    var = jnp.mean(jnp.square(xf - mu), axis=-1, keepdims=True)
    y = (xf - mu) * lax.rsqrt(var + LN_EPS) * w.astype(jnp.float32) + b.astype(jnp.float32)
    return y.astype(x.dtype)


def rms_norm(x, w):
    xf = x.astype(jnp.float32)
    y = xf * lax.rsqrt(jnp.mean(jnp.square(xf), axis=-1, keepdims=True) + RMS_EPS) * w.astype(jnp.float32)
    return y.astype(x.dtype)


def hgrn2_chunk_scan(q, k, v, logf, s0):
    bsz, t = q.shape[0], q.shape[1]
    pad = (-t) % CHUNK
    pw = ((0, 0), (0, pad), (0, 0), (0, 0))
    q, k, v, logf = (jnp.pad(a, pw) for a in (q, k, v, logf))
    nc = (t + pad) // CHUNK

    def to_chunks(a):
        return a.reshape(bsz, nc, CHUNK, a.shape[2], a.shape[3]).swapaxes(0, 1)

    causal = jnp.tril(jnp.ones((CHUNK, CHUNK), dtype=bool))

    def step(s, xs):
        qc, kc, vc, lc = xs
        b = jnp.cumsum(lc, axis=1)
        bm = b[:, CHUNK // 2 - 1][:, None]
        bl = b[:, -1]
        qh = qc * jnp.exp(b - bm)
        kh = kc * jnp.exp(bm - b)
        att = jnp.where(causal, jnp.einsum('bthk,bshk->bhts', qh, kh), 0.0)
        o = (jnp.einsum('bhts,bshv->bthv', att, vc)
             + jnp.einsum('bthk,bhkv->bthv', qc * jnp.exp(b), s))
        s_new = (jnp.exp(bl)[..., None] * s
                 + jnp.einsum('bshk,bshv->bhkv', kc * jnp.exp(bl[:, None] - b), vc))
        return s_new, o

    s_fin, o = lax.scan(step, s0, (to_chunks(q), to_chunks(k), to_chunks(v), to_chunks(logf)))
    o = o.swapaxes(0, 1).reshape(bsz, nc * CHUNK, o.shape[3], o.shape[4])[:, :t]
    return o, s_fin


def hgrn2_mixer(x, s0, w_in, lb, gnorm_w, w_out):
    bsz, t, _ = x.shape
    q, fz, v, g = jnp.split(x @ w_in, 4, axis=-1)

    def heads(a):
        return a.reshape(bsz, t, HG_HEADS, HG_HEAD_DIM)

    lbf = lb.astype(jnp.float32)
    f = lbf + (1.0 - lbf) * jax.nn.sigmoid(fz.astype(jnp.float32))
    qh = heads(jax.nn.silu(q.astype(jnp.float32)) * HG_QK_SCALE)
    kh = heads(1.0 - f)
    o, s = hgrn2_chunk_scan(qh, kh, heads(v.astype(jnp.float32)), heads(jnp.log(f)),
                            s0.astype(jnp.float32))
    o = rms_norm(o, gnorm_w) * jax.nn.silu(heads(g.astype(jnp.float32)))
    o = o.reshape(bsz, t, D_MODEL).astype(x.dtype)
    return o @ w_out, s


def s5_combine(e1, e2):
    a1, b1 = e1
    a2, b2 = e2
    return a1 * a2, a2 * b1 + b2


def s5_mixer(x, h0_re, h0_im, a_re, a_im, b_re, b_im, c_re, c_im, d_skip, log_step, w_glu):
    bsz, t, _ = x.shape
    f32 = jnp.float32
    u = x.astype(f32).reshape(bsz, t, S5_GROUPS, S5_GROUP)
    lam = lax.complex(a_re.astype(f32), a_im.astype(f32))
    delta = jnp.exp(log_step.astype(f32))[:, None]
    lam_bar = jnp.exp(lam * delta)
    b_bar = ((lam_bar - 1.0) / lam)[..., None] * lax.complex(b_re.astype(f32), b_im.astype(f32))
    c_mat = lax.complex(c_re.astype(f32), c_im.astype(f32))
    bu = jnp.einsum('btgc,gpc->btgp', u.astype(jnp.complex64), b_bar)
    h0 = lax.complex(h0_re.astype(f32), h0_im.astype(f32))
    bu = bu.at[:, 0].add(lam_bar * h0)
    a_el = jnp.broadcast_to(lam_bar, (1, t, S5_GROUPS, S5_STATE))
    _, h = lax.associative_scan(s5_combine, (a_el, bu), axis=1)
    y = jnp.einsum('btgp,gcp->btgc', h, c_mat).real + d_skip.astype(f32).reshape(S5_GROUPS, S5_GROUP) * u
    y = jax.nn.gelu(y.reshape(bsz, t, D_MODEL)).astype(x.dtype)
    val, gate = jnp.split(y @ w_glu, 2, axis=-1)
    h_last = h[:, -1]
    return val * jax.nn.sigmoid(gate), h_last.real, h_last.imag


def swiglu(x, w_gate_up, w_down):
    g, u = jnp.split(x @ w_gate_up, 2, axis=-1)
    return (jax.nn.silu(g) * u) @ w_down


def per_layer_embed(x, p_i, w_proj, w_gate, norm_w):
    e = (p_i @ w_proj).astype(jnp.float32) * jax.nn.sigmoid((x @ w_gate).astype(jnp.float32))
    return x + rms_norm(e, norm_w).astype(x.dtype)


def trunk(x, p, st_hg, st_re, st_im, lb,
          hg_w_in, hg_gnorm_w, hg_w_out,
          s5_a_re, s5_a_im, s5_b_re, s5_b_im, s5_c_re, s5_c_im, s5_d, s5_log_step, s5_w_glu,
          ln_mix_w, ln_mix_b, ffn_w_gate_up, ffn_w_down, ln_ffn_w, ln_ffn_b,
          ple_w_proj, ple_w_gate, ple_norm_w):
    new_hg, new_re, new_im = [], [], []
    for i in range(DEPTH):
        j = i // N_MIXERS
        if i % N_MIXERS == 0:
            mix, s = hgrn2_mixer(x, st_hg[j], hg_w_in[j], lb[j], hg_gnorm_w[j], hg_w_out[j])
            new_hg.append(s)
        else:
            mix, hr, hi = s5_mixer(x, st_re[j], st_im[j], s5_a_re[j], s5_a_im[j], s5_b_re[j], s5_b_im[j],
                                   s5_c_re[j], s5_c_im[j], s5_d[j], s5_log_step[j], s5_w_glu[j])
            new_re.append(hr)
            new_im.append(hi)
        x = layer_norm(ALPHA * x + mix, ln_mix_w[i], ln_mix_b[i])
        x = layer_norm(ALPHA * x + swiglu(x, ffn_w_gate_up[i], ffn_w_down[i]), ln_ffn_w[i], ln_ffn_b[i])
        x = per_layer_embed(x, p[i], ple_w_proj[i], ple_w_gate[i], ple_norm_w[i])
    return x, jnp.stack(new_hg), jnp.stack(new_re), jnp.stack(new_im)


def setup_inputs(seed: int = 0) -> dict:
    key = jax.random.key(seed)
    ks = jax.random.split(key, 32)
    f32 = jnp.float32

    def nrm(k, shape, s):
        return jax.random.normal(k, shape, f32) * s

    s5_a_im = (jnp.pi * jnp.arange(S5_STATE, dtype=f32))[None, None, :] + nrm(ks[12], (N_S5, S5_GROUPS, S5_STATE), 0.01)
    return {
        'x_prompt': nrm(ks[0], (BATCH, SEQ, D_MODEL), 1.0),
        'x_sample': nrm(ks[1], (DEC_BATCH, DEC_SEQ, D_MODEL), 1.0),
        'state_hgrn': nrm(ks[2], (N_HGRN, DEC_BATCH, HG_HEADS, HG_HEAD_DIM, HG_HEAD_DIM), 0.5),
        'state_s5_re': nrm(ks[3], (N_S5, DEC_BATCH, S5_GROUPS, S5_STATE), 0.1),
        'state_s5_im': nrm(ks[4], (N_S5, DEC_BATCH, S5_GROUPS, S5_STATE), 0.1),
        'p_prompt': nrm(ks[5], (DEPTH, BATCH, SEQ, PLE_DIM), 1.0),
        'p_sample': nrm(ks[6], (DEPTH, DEC_BATCH, DEC_SEQ, PLE_DIM), 1.0),
        'hg_w_in': nrm(ks[7], (N_HGRN, D_MODEL, 4 * D_MODEL), D_MODEL ** -0.5),
        'hg_lower_bounds': nrm(ks[8], (N_HGRN, D_MODEL), 0.1),
        'hg_gnorm_w': 1.0 + nrm(ks[9], (N_HGRN, HG_HEAD_DIM), 0.01),
        'hg_w_out': nrm(ks[10], (N_HGRN, D_MODEL, D_MODEL), BETA * D_MODEL ** -0.5),
        's5_a_re': -0.5 + nrm(ks[11], (N_S5, S5_GROUPS, S5_STATE), 0.01),
        's5_a_im': s5_a_im,
        's5_b_re': nrm(ks[13], (N_S5, S5_GROUPS, S5_STATE, S5_GROUP), (2 * S5_GROUP) ** -0.5),
        's5_b_im': nrm(ks[14], (N_S5, S5_GROUPS, S5_STATE, S5_GROUP), (2 * S5_GROUP) ** -0.5),
        's5_c_re': nrm(ks[15], (N_S5, S5_GROUPS, S5_GROUP, S5_STATE), (2 * S5_STATE) ** -0.5),
        's5_c_im': nrm(ks[16], (N_S5, S5_GROUPS, S5_GROUP, S5_STATE), (2 * S5_STATE) ** -0.5),
        's5_d': nrm(ks[17], (N_S5, D_MODEL), 1.0),
        's5_log_step': jax.random.uniform(ks[18], (N_S5, S5_GROUPS), f32, math.log(1e-3), math.log(1e-1)),
        's5_w_glu': nrm(ks[19], (N_S5, D_MODEL, 2 * D_MODEL), BETA * D_MODEL ** -0.5),
        'ln_mix_w': 1.0 + nrm(ks[20], (DEPTH, D_MODEL), 0.01),
        'ln_mix_b': nrm(ks[21], (DEPTH, D_MODEL), 0.01),
        'ffn_w_gate_up': nrm(ks[22], (DEPTH, D_MODEL, 2 * D_FF), D_MODEL ** -0.5),
        'ffn_w_down': nrm(ks[23], (DEPTH, D_FF, D_MODEL), BETA * D_FF ** -0.5),
        'ln_ffn_w': 1.0 + nrm(ks[24], (DEPTH, D_MODEL), 0.01),
        'ln_ffn_b': nrm(ks[25], (DEPTH, D_MODEL), 0.01),
        'ple_w_proj': nrm(ks[26], (DEPTH, PLE_DIM, D_MODEL), PLE_DIM ** -0.5),
        'ple_w_gate': nrm(ks[27], (DEPTH, D_MODEL, D_MODEL), D_MODEL ** -0.5),
        'ple_norm_w': 1.0 + nrm(ks[28], (DEPTH, D_MODEL), 0.01),
    }


def reference(x_prompt, x_sample, state_hgrn, state_s5_re, state_s5_im, p_prompt, p_sample,
              hg_w_in, hg_lower_bounds, hg_gnorm_w, hg_w_out,
              s5_a_re, s5_a_im, s5_b_re, s5_b_im, s5_c_re, s5_c_im, s5_d, s5_log_step, s5_w_glu,
              ln_mix_w, ln_mix_b, ffn_w_gate_up, ffn_w_down, ln_ffn_w, ln_ffn_b,
              ple_w_proj, ple_w_gate, ple_norm_w):
    lb_soft = jax.nn.softmax(hg_lower_bounds.astype(jnp.float32), axis=0)
    lb = jnp.cumsum(lb_soft, axis=0) - lb_soft[0]
    weights = (hg_w_in, hg_gnorm_w, hg_w_out,
               s5_a_re, s5_a_im, s5_b_re, s5_b_im, s5_c_re, s5_c_im, s5_d, s5_log_step, s5_w_glu,
               ln_mix_w, ln_mix_b, ffn_w_gate_up, ffn_w_down, ln_ffn_w, ln_ffn_b,
               ple_w_proj, ple_w_gate, ple_norm_w)
    zero_hg = jnp.zeros((N_HGRN, BATCH, HG_HEADS, HG_HEAD_DIM, HG_HEAD_DIM), jnp.float32)
    zero_s5 = jnp.zeros((N_S5, BATCH, S5_GROUPS, S5_STATE), jnp.float32)
    y_prompt, hg_p, re_p, im_p = trunk(x_prompt, p_prompt, zero_hg, zero_s5, zero_s5, lb, *weights)
    y_sample, hg_s, re_s, im_s = trunk(x_sample, p_sample, state_hgrn, state_s5_re, state_s5_im, lb, *weights)
    return (y_prompt, y_sample, hg_p, re_p, im_p, hg_s, re_s, im_s)
```

```cpp
#include <hip/hip_runtime.h>
#include <hip/hip_cooperative_groups.h>
#include <cstdio>
namespace cg = cooperative_groups;

#define LAS __attribute__((address_space(3)))
typedef unsigned short bf16_t;
typedef short bf16x8 __attribute__((ext_vector_type(8)));
typedef float f32x4 __attribute__((ext_vector_type(4)));
typedef float f32x2 __attribute__((ext_vector_type(2)));
typedef float f32x16 __attribute__((ext_vector_type(16)));
typedef unsigned u32x4 __attribute__((ext_vector_type(4)));
typedef unsigned u32x2 __attribute__((ext_vector_type(2)));
typedef __bf16 bf2_t __attribute__((ext_vector_type(2)));
#define DI __device__ __forceinline__

constexpr int D = 1024, NTOK = 17408, NPR = 16384;
constexpr int DFF = 2816, PLED = 256;
constexpr float ALPHA = 1.681792830507429f;
constexpr float QK_SCALE = 0.08838834764831845f;
constexpr float LN_EPS = 1e-5f, RMS_EPS = 1e-6f;
constexpr int LDS_BYTES = 139264;
constexpr int NITEM_HG = 5120;

constexpr size_t WS_WIN = 0;
constexpr size_t WS_WOUT = WS_WIN + 16777216;
constexpr size_t WS_WGLU = WS_WOUT + 4194304;
constexpr size_t WS_WUP = WS_WGLU + 8388608;
constexpr size_t WS_WDN = WS_WUP + 46137344;
constexpr size_t WS_WPG = WS_WDN + 23068672;
constexpr size_t WS_WPP = WS_WPG + 8388608;
constexpr size_t WS_QT = WS_WPP + 2097152;
constexpr size_t WS_TPT = WS_QT + 4194304;
constexpr size_t WS_LAM8 = WS_TPT + 8388608;
constexpr size_t WS_LB = WS_LAM8 + 65536;
constexpr size_t WS_PB = WS_LB + 8192;
constexpr size_t WS_XB = WS_PB + 35651584;
constexpr size_t WS_U = WS_XB + 35651584;
constexpr size_t U_Q = 0, U_LF = 35651584, U_V = 106954752, U_G = 142606336, U_FR = 178257920;
constexpr size_t U_QE = U_FR, U_KDT = U_QE + (size_t)NITEM_HG * 8192, U_ATT = U_KDT + (size_t)NITEM_HG * 8192, U_VF = U_ATT + (size_t)NITEM_HG * 2048, U_DEC = U_VF + (size_t)NITEM_HG * 8192;
constexpr size_t U_Z = 178257920;
constexpr size_t U_H = 0, U_P = 0, U_E = 0, U_HPREV = 71303168, U_YB = 106954752;
constexpr size_t WS_END = WS_U + U_DEC + (size_t)NITEM_HG * 512;

constexpr size_t O_Y = 0, O_HGP = 17825792, O_REP = 19922944, O_IMP = 19988480, O_HGS = 20054016, O_RES = 53608448, O_IMS = 54657024;

struct Params { const float* in[29]; float* out; unsigned char* ws; };

DI unsigned pack2(float lo, float hi) { f32x2 v = {lo, hi}; bf2_t b = __builtin_convertvector(v, bf2_t); return __builtin_bit_cast(unsigned, b); }
DI float bf_lo(unsigned u) { return __uint_as_float(u << 16); }
DI float bf_hi(unsigned u) { return __uint_as_float(u & 0xffff0000u); }
DI float frcp(float x) { return __builtin_amdgcn_rcpf(x); }
DI float sigm(float x) { return frcp(1.0f + __expf(-x)); }
DI float silu(float x) { return x * sigm(x); }
DI float gelu_tanh(float y) { const float u = 0.7978845608028654f * (y + 0.044715f * y * y * y); const float t = 1.0f - 2.0f * frcp(__expf(2.0f * u) + 1.0f); return 0.5f * y * (1.0f + t); }
DI float wave_sum(float v) { for (int o = 32; o >= 1; o >>= 1) v += __shfl_xor(v, o); return v; }
DI int opq(int x) { asm volatile("" : "+v"(x)); return x; }
DI int opqs(int x) { asm volatile("" : "+s"(x)); return x; }
DI int crow(int reg, int h) { return (reg & 3) + 8 * (reg >> 2) + 4 * h; }
#define MFMA32(a, b, c) __builtin_amdgcn_mfma_f32_32x32x16_bf16((a), (b), (c), 0, 0, 0)
DI bf16x8 pack8(float a0, float a1, float a2, float a3, float a4, float a5, float a6, float a7) {
    u32x4 p; p.x = pack2(a0, a1); p.y = pack2(a2, a3); p.z = pack2(a4, a5); p.w = pack2(a6, a7); return __builtin_bit_cast(bf16x8, p);
}

namespace pg8 {
constexpr int BM = 256, BK = 64, HALF = 128, HTB = HALF * BK * 2, NXCD = 8, WGM = 8;
DI int lds_byte(int r, int c) { const int st = (r >> 4) * 2 + (c >> 5), rr = r & 15, cc = c & 31, ob = rr * 64 + cc * 2; return st * 1024 + (ob ^ (((ob >> 9) & 1) << 5)); }
DI void stage_rc(int b, int& R, int& C) { const int st = b / 1024, sb = b % 1024, swz = sb ^ (((sb >> 9) & 1) << 5); R = (st >> 1) * 16 + swz / 64; C = (st & 1) * 32 + (swz % 64) / 2; }
struct Unit { int pm, pn; };
struct Gemm { const bf16_t* A; const bf16_t* Bt; int M, N, K; };
struct StaticOrder {
    int nM, nN, nwg, G, c;
    DI void init(int M, int N, int G_, int c_) { nM = M / BM; nN = N / BM; nwg = nM * nN; G = G_; c = c_; }
    DI bool next(int i, Unit& u) const {
        const long L = (long)i * G + c; if (L >= nwg) return false;
        int wgid = (int)L; { const int q = nwg / NXCD, r = nwg % NXCD, xcd = wgid % NXCD, off = wgid / NXCD; wgid = (xcd < r ? xcd * (q + 1) : r * (q + 1) + (xcd - r) * q) + off; }
        const int nig = WGM * nN, gid = wgid / nig, fm = gid * WGM, gsz = (nM - fm) < WGM ? (nM - fm) : WGM;
        u.pm = fm + ((wgid % nig) % gsz); u.pn = (wgid % nig) / gsz; return true;
    }
};

template <class Epi>
DI void gemm_phase(LAS unsigned char* lds, const Gemm g, const StaticOrder& S, const Epi& E) {
    const int tid = opq(threadIdx.x), wid = __builtin_amdgcn_readfirstlane(tid >> 6), lane = tid & 63, wr = wid >> 2, wc = wid & 3, fr = lane & 15, fq = lane >> 4;
    const int K = g.K, nt = K / BK;
    unsigned voffA[2];
#pragma unroll
    for (int i = 0; i < 2; ++i) { int R, C; stage_rc(tid * 16 + i * 8192, R, C); voffA[i] = (unsigned)(R * K + C) * 2u; }
    const size_t kstep = (size_t)(BK * 2);
    const size_t hstep = (size_t)HALF * K * 2;
    const size_t tstep = 2 * hstep;
    const unsigned ldsw = (unsigned)wid * 1024u;
    const int aoff = lds_byte(wr * 64 + fr, fq * 8), boff = lds_byte(wc * 32 + fr, fq * 8);
#define PG8_SA(b, h) (((b) * 2 + (h)) * HTB)
#define PG8_SB(b, h) ((4 + (b) * 2 + (h)) * HTB)
#define PG8_STAGE(bufoff, gbase) do { _Pragma("unroll") for (int _i = 0; _i < 2; ++_i) \
        __builtin_amdgcn_global_load_lds((const unsigned*)((const char*)(gbase) + voffA[_i]), (LAS unsigned*)(lds + (bufoff) + ldsw + _i * 8192), 16, 0, 0); } while (0)
#define PG8_LDA(dst, b, h) do { _Pragma("unroll") for (int m = 0; m < 4; ++m) _Pragma("unroll") for (int k = 0; k < 2; ++k) dst[m][k] = *(const LAS bf16x8*)(lds + PG8_SA(b, h) + aoff + m * 2048 + k * 1024); } while (0)
#define PG8_LDB(dst, b, h) do { _Pragma("unroll") for (int n = 0; n < 2; ++n) _Pragma("unroll") for (int k = 0; k < 2; ++k) dst[n][k] = *(const LAS bf16x8*)(lds + PG8_SB(b, h) + boff + n * 2048 + k * 1024); } while (0)
#define PG8_MMA(ai, bj, At, Bt) do { __builtin_amdgcn_s_setprio(1); _Pragma("unroll") for (int m = 0; m < 4; ++m) _Pragma("unroll") for (int n = 0; n < 2; ++n) _Pragma("unroll") for (int k = 0; k < 2; ++k) \
        acc[ai][bj][m][n] = __builtin_amdgcn_mfma_f32_16x16x32_bf16(Bt[n][k], At[m][k], acc[ai][bj][m][n], 0, 0, 0); __builtin_amdgcn_s_setprio(0); } while (0)
#define PG8_WAIT_V(n) asm volatile("s_waitcnt vmcnt(" #n ")" ::: "memory")
#define PG8_WAIT_L(n) asm volatile("s_waitcnt lgkmcnt(" #n ")" ::: "memory")
#define PG8_BAR __builtin_amdgcn_s_barrier()
#define PG8_SCHED __builtin_amdgcn_sched_barrier(0)
    Unit cur, nxt; int ui = 0;
    if (!S.next(0, cur)) return;
    f32x4 acc[2][2][4][2];
#pragma unroll
    for (int a = 0; a < 2; ++a)
#pragma unroll
        for (int b = 0; b < 2; ++b)
#pragma unroll
            for (int m = 0; m < 4; ++m)
#pragma unroll
                for (int n = 0; n < 2; ++n) acc[a][b][m][n] = (f32x4){0.f, 0.f, 0.f, 0.f};
    bf16x8 At[4][2], B0[2][2], B1[2][2];
    const char* cA = (const char*)g.A + (size_t)cur.pm * tstep; const char* cB = (const char*)g.Bt + (size_t)cur.pn * tstep;
    PG8_STAGE(PG8_SB(0, 0), cB); PG8_STAGE(PG8_SA(0, 0), cA); PG8_STAGE(PG8_SB(0, 1), cB + hstep); PG8_STAGE(PG8_SA(0, 1), cA + hstep);
    if (wr == 1) PG8_BAR;
    PG8_WAIT_V(4); PG8_BAR;
    PG8_STAGE(PG8_SB(1, 0), cB + kstep); PG8_STAGE(PG8_SA(1, 0), cA + kstep); PG8_STAGE(PG8_SB(1, 1), cB + hstep + kstep);
    PG8_WAIT_V(6); PG8_BAR;
    for (;;) {
        const bool has_next = S.next(ui + 1, nxt);
        const char* nA = has_next ? (const char*)g.A + (size_t)nxt.pm * tstep : cA; const char* nB = has_next ? (const char*)g.Bt + (size_t)nxt.pn * tstep : cB;
        for (int t = 0; t < nt; t += 2) {
            const bool last = (t == nt - 2);
            const char* a1 = cA + (size_t)(t + 1) * kstep;
            const char* a2 = last ? nA : cA + (size_t)(t + 2) * kstep; const char* b2 = last ? nB : cB + (size_t)(t + 2) * kstep;
            const char* a3 = a2 + kstep; const char* b3 = b2 + kstep;
            PG8_LDB(B0, 0, 0); PG8_SCHED; PG8_LDA(At, 0, 0); PG8_STAGE(PG8_SA(1, 1), a1 + hstep);
            PG8_WAIT_L(8); PG8_BAR; PG8_WAIT_L(0); PG8_MMA(0, 0, At, B0); PG8_BAR; PG8_SCHED;
            PG8_LDB(B1, 0, 1); PG8_STAGE(PG8_SB(0, 0), b2);
            PG8_BAR; PG8_WAIT_L(0); PG8_MMA(0, 1, At, B1); PG8_BAR;
            PG8_LDA(At, 0, 1); PG8_STAGE(PG8_SA(0, 0), a2);
            PG8_BAR; PG8_WAIT_L(0); PG8_MMA(1, 0, At, B0); PG8_BAR; PG8_SCHED;
            PG8_STAGE(PG8_SB(0, 1), b2 + hstep);
            PG8_WAIT_V(6); PG8_BAR; PG8_MMA(1, 1, At, B1); PG8_BAR;
            PG8_LDB(B0, 1, 0); PG8_SCHED; PG8_LDA(At, 1, 0); PG8_STAGE(PG8_SA(0, 1), a2 + hstep);
            PG8_WAIT_L(8); PG8_BAR; PG8_WAIT_L(0); PG8_MMA(0, 0, At, B0); PG8_BAR; PG8_SCHED;
            PG8_LDB(B1, 1, 1); PG8_STAGE(PG8_SB(1, 0), b3);
            PG8_BAR; PG8_WAIT_L(0); PG8_MMA(0, 1, At, B1); PG8_BAR;
            PG8_LDA(At, 1, 1); PG8_STAGE(PG8_SA(1, 0), a3);
            PG8_BAR; PG8_WAIT_L(0); PG8_MMA(1, 0, At, B0); PG8_BAR; PG8_SCHED;
            PG8_STAGE(PG8_SB(1, 1), b3 + hstep);
            PG8_WAIT_V(6); PG8_BAR; PG8_MMA(1, 1, At, B1); PG8_BAR;
        }
        E(acc, cur, wr, wc, fr, fq);
        if (!has_next) break;
#pragma unroll
        for (int a = 0; a < 2; ++a)
#pragma unroll
            for (int b = 0; b < 2; ++b)
#pragma unroll
                for (int m = 0; m < 4; ++m)
#pragma unroll
                    for (int n = 0; n < 2; ++n) acc[a][b][m][n] = (f32x4){0.f, 0.f, 0.f, 0.f};
        cur = nxt; cA = nA; cB = nB; ++ui;
    }
    PG8_WAIT_V(0);
    if (wr == 0) PG8_BAR;
    PG8_BAR;
#undef PG8_SA
#undef PG8_SB
#undef PG8_STAGE
#undef PG8_LDA
#undef PG8_LDB
#undef PG8_MMA
#undef PG8_WAIT_V
#undef PG8_WAIT_L
#undef PG8_BAR
#undef PG8_SCHED
}
}
using pg8::Unit;
typedef const f32x4 (&AccRef)[2][2][4][2];

DI void st_bf4(bf16_t* p, f32x4 v) { u32x2 w; w.x = pack2(v[0], v[1]); w.y = pack2(v[2], v[3]); *(u32x2*)p = w; }

struct EpiWin {
    bf16_t* Q; float* LF; bf16_t* V; bf16_t* G; const float* lb;
    DI void operator()(AccRef acc, const Unit& u, int wr, int wc, int fr, int fq) const {
        const int sec = u.pn >> 2;
        const int row0 = u.pm * 256 + wr * 64 + fr, col0 = (u.pn & 3) * 256 + wc * 32 + 4 * fq;
#pragma unroll
        for (int ai = 0; ai < 2; ++ai)
#pragma unroll
            for (int m = 0; m < 4; ++m) {
                const size_t ro = (size_t)(row0 + ai * 128 + m * 16) * D;
#pragma unroll
                for (int bj = 0; bj < 2; ++bj)
#pragma unroll
                    for (int n = 0; n < 2; ++n) {
                        const int col = col0 + bj * 128 + n * 16; const f32x4 a = acc[ai][bj][m][n]; f32x4 o;
                        if (sec == 0) { for (int j = 0; j < 4; ++j) o[j] = silu(a[j]) * QK_SCALE; st_bf4(Q + ro + col, o); }
                        else if (sec == 1) { const f32x4 l = *(const f32x4*)(lb + col); for (int j = 0; j < 4; ++j) o[j] = __logf(l[j] + (1.0f - l[j]) * sigm(a[j])); *(f32x4*)(LF + ro + col) = o; }
                        else if (sec == 2) { st_bf4(V + ro + col, a); }
                        else { for (int j = 0; j < 4; ++j) o[j] = silu(a[j]); st_bf4(G + ro + col, o); }
                    }
            }
    }
};
struct EpiRes {
    const float* X; float* Z;
    DI void operator()(AccRef acc, const Unit& u, int wr, int wc, int fr, int fq) const {
        const int row0 = u.pm * 256 + wr * 64 + fr, col0 = u.pn * 256 + wc * 32 + 4 * fq;
#pragma unroll
        for (int ai = 0; ai < 2; ++ai)
#pragma unroll
            for (int m = 0; m < 4; ++m) {
                const size_t ro = (size_t)(row0 + ai * 128 + m * 16) * D + col0;
#pragma unroll
                for (int bj = 0; bj < 2; ++bj)
#pragma unroll
                    for (int n = 0; n < 2; ++n) { const f32x4 x = *(const f32x4*)(X + ro + bj * 128 + n * 16); *(f32x4*)(Z + ro + bj * 128 + n * 16) = x * ALPHA + acc[ai][bj][m][n]; }
                asm volatile("" ::: "memory");
            }
    }
};
struct EpiGlu {
    const float* X; float* Z;
    DI void operator()(AccRef acc, const Unit& u, int wr, int wc, int fr, int fq) const {
        const int row0 = u.pm * 256 + wr * 64 + fr, col0 = u.pn * 128 + wc * 32 + 4 * fq;
#pragma unroll
        for (int ai = 0; ai < 2; ++ai)
#pragma unroll
            for (int m = 0; m < 4; ++m) {
                const size_t ro = (size_t)(row0 + ai * 128 + m * 16) * D + col0;
#pragma unroll
                for (int n = 0; n < 2; ++n) { const f32x4 x = *(const f32x4*)(X + ro + n * 16); const f32x4 v = acc[ai][0][m][n], gt = acc[ai][1][m][n]; f32x4 o;
                    for (int j = 0; j < 4; ++j) o[j] = x[j] * ALPHA + v[j] * sigm(gt[j]); *(f32x4*)(Z + ro + n * 16) = o; }
            }
    }
};
struct EpiSwi {
    bf16_t* H;
    DI void operator()(AccRef acc, const Unit& u, int wr, int wc, int fr, int fq) const {
        const int row0 = u.pm * 256 + wr * 64 + fr, col0 = u.pn * 128 + wc * 32 + 4 * fq;
#pragma unroll
        for (int ai = 0; ai < 2; ++ai)
#pragma unroll
            for (int m = 0; m < 4; ++m) {
                const size_t ro = (size_t)(row0 + ai * 128 + m * 16) * DFF + col0;
#pragma unroll
                for (int n = 0; n < 2; ++n) { const f32x4 gt = acc[ai][0][m][n], up = acc[ai][1][m][n]; f32x4 o; for (int j = 0; j < 4; ++j) o[j] = silu(gt[j]) * up[j]; st_bf4(H + ro + n * 16, o); }
            }
    }
};
struct EpiF32 {
    float* C;
    DI void operator()(AccRef acc, const Unit& u, int wr, int wc, int fr, int fq) const {
        const int row0 = u.pm * 256 + wr * 64 + fr, col0 = u.pn * 256 + wc * 32 + 4 * fq;
#pragma unroll
        for (int ai = 0; ai < 2; ++ai)
#pragma unroll
            for (int m = 0; m < 4; ++m) {
                const size_t ro = (size_t)(row0 + ai * 128 + m * 16) * D + col0;
#pragma unroll
                for (int bj = 0; bj < 2; ++bj)
#pragma unroll
                    for (int n = 0; n < 2; ++n) *(f32x4*)(C + ro + bj * 128 + n * 16) = acc[ai][bj][m][n];
            }
    }
};
struct EpiPleGate {
    float* C;
    DI void operator()(AccRef acc, const Unit& u, int wr, int wc, int fr, int fq) const {
        const int row0 = u.pm * 256 + wr * 64 + fr, col0 = u.pn * 256 + wc * 32 + 4 * fq;
#pragma unroll
        for (int ai = 0; ai < 2; ++ai)
#pragma unroll
            for (int m = 0; m < 4; ++m) {
                const size_t ro = (size_t)(row0 + ai * 128 + m * 16) * D + col0;
#pragma unroll
                for (int bj = 0; bj < 2; ++bj)
#pragma unroll
                    for (int n = 0; n < 2; ++n) { const f32x4 pv = *(const f32x4*)(C + ro + bj * 128 + n * 16); const f32x4 a = acc[ai][bj][m][n]; f32x4 o; for (int j = 0; j < 4; ++j) o[j] = pv[j] * sigm(a[j]); *(f32x4*)(C + ro + bj * 128 + n * 16) = o; }
                asm volatile("" ::: "memory");
            }
    }
};

DI void prep_transpose(LAS float* tl, const float* src, bf16_t* dst, int K, int N, int mode, int H) {
    const int tid = opq(threadIdx.x); const int tn = N >> 6; const int ntiles = (K >> 6) * tn;
    for (int tile = blockIdx.x; tile < ntiles; tile += gridDim.x) {
        const int n0 = (tile % tn) * 64, k0 = (tile / tn) * 64;
        int sc0 = n0; if (mode) { const int t = n0 >> 8, r = n0 & 255; sc0 = (r < 128) ? 128 * t + r : H + 128 * t + (r - 128); }
        __syncthreads();
#pragma unroll
        for (int r = 0; r < 8; ++r) { const int k = r * 8 + (tid >> 6), n = tid & 63; tl[k * 65 + n] = src[(size_t)(k0 + k) * N + sc0 + n]; }
        __syncthreads();
#pragma unroll
        for (int r = 0; r < 4; ++r) { const int n = r * 16 + (tid >> 5), k = 2 * (tid & 31); *(unsigned*)(dst + (size_t)(n0 + n) * K + k0 + k) = pack2(tl[k * 65 + n], tl[(k + 1) * 65 + n]); }
    }
}

DI void prep_s5(LAS unsigned char* lds, const Params& P, int j, int g, bf16_t* QT, bf16_t* TPT, f32x2* LAM8) {
    LAS f32x2* powc = (LAS f32x2*)lds;
    LAS f32x2* Bb = powc + 9 * 64;
    LAS f32x2* Cc = Bb + 1024;
    LAS f32x2* coef = Cc + 1024;
    LAS float* Mm = (LAS float*)(coef + 64);
    const int tid = opq(threadIdx.x);
    const float* a_re = P.in[11] + (size_t)(j * 64 + g) * 64; const float* a_im = P.in[12] + (size_t)(j * 64 + g) * 64;
    const float* b_re = P.in[13] + (size_t)(j * 64 + g) * 1024; const float* b_im = P.in[14] + (size_t)(j * 64 + g) * 1024;
    const float* c_re = P.in[15] + (size_t)(j * 64 + g) * 1024; const float* c_im = P.in[16] + (size_t)(j * 64 + g) * 1024;
    const float* dsk = P.in[17] + (size_t)j * D + g * 16;
    __syncthreads();
    if (tid < 64) {
        const float ar = a_re[tid], ai = a_im[tid]; const float dl = __expf(P.in[18][j * 64 + g]);
        for (int t = 0; t <= 8; ++t) {
            const float mag = __expf(ar * dl * (float)t);
            const double ang = (double)ai * (double)dl * (double)t; const double nrev = rint(ang * 0.15915494309189535); const float r = (float)(ang - nrev * 6.283185307179586);
            powc[t * 64 + tid] = (f32x2){mag * __cosf(r), mag * __sinf(r)};
        }
        const f32x2 lb1 = powc[64 + tid]; const float nr = lb1.x - 1.0f, ni = lb1.y; const float den = frcp(ar * ar + ai * ai);
        coef[tid] = (f32x2){(nr * ar + ni * ai) * den, (ni * ar - nr * ai) * den};
    }
    __syncthreads();
    for (int e = tid; e < 1024; e += 512) { const int p = e >> 4; const f32x2 cf = coef[p]; const float br = b_re[e], bi = b_im[e]; Bb[e] = (f32x2){cf.x * br - cf.y * bi, cf.x * bi + cf.y * br}; Cc[e] = (f32x2){c_re[e], c_im[e]}; }
    __syncthreads();
    for (int e = tid; e < 2048; e += 512) { const int tau = e >> 8, c = (e >> 4) & 15, c2 = e & 15; float s = 0.f;
        for (int p = 0; p < 64; ++p) { const f32x2 cv = Cc[c * 64 + p], pw = powc[tau * 64 + p], bv = Bb[p * 16 + c2]; const float wr_ = cv.x * pw.x - cv.y * pw.y, wi_ = cv.x * pw.y + cv.y * pw.x; s += wr_ * bv.x - wi_ * bv.y; }
        Mm[e] = s; }
    __syncthreads();
    bf16_t* tp = TPT + (size_t)(j * 64 + g) * 32768;
    for (int e = tid; e < 32768; e += 512) { const int n = e >> 8, k = e & 255, jj = n >> 4, c = n & 15; float val;
        if (k < 128) { const int i = k >> 4, c2 = k & 15; val = (i <= jj) ? Mm[((jj - i) << 8) + (c << 4) + c2] : 0.f; if (i == jj && c == c2) val += dsk[c]; }
        else { const int kk = k - 128, p = kk >> 1; const f32x2 cv = Cc[c * 64 + p], pw = powc[(jj + 1) * 64 + p]; val = (kk & 1) ? -(cv.x * pw.y + cv.y * pw.x) : (cv.x * pw.x - cv.y * pw.y); }
        tp[e] = (bf16_t)pack2(val, 0.f); }
    bf16_t* qt = QT + (size_t)(j * 64 + g) * 16384;
    for (int e = tid; e < 16384; e += 512) { const int n = e >> 7, k = e & 127, p = n >> 1, i = k >> 4, c2 = k & 15; const f32x2 pw = powc[(7 - i) * 64 + p], bv = Bb[p * 16 + c2];
        const float val = (n & 1) ? (pw.x * bv.y + pw.y * bv.x) : (pw.x * bv.x - pw.y * bv.y); qt[e] = (bf16_t)pack2(val, 0.f); }
    if (tid < 64) LAM8[(size_t)(j * 64 + g) * 64 + tid] = powc[8 * 64 + tid];
}

DI void prep_phase(LAS unsigned char* lds, const Params& P) {
    unsigned char* ws = P.ws;
    LAS float* tl = (LAS float*)lds;
    for (int j = 0; j < 2; ++j) {
        prep_transpose(tl, P.in[7] + (size_t)j * 4194304, (bf16_t*)(ws + WS_WIN) + (size_t)j * 4194304, 1024, 4096, 0, 0);
        prep_transpose(tl, P.in[10] + (size_t)j * 1048576, (bf16_t*)(ws + WS_WOUT) + (size_t)j * 1048576, 1024, 1024, 0, 0);
        prep_transpose(tl, P.in[19] + (size_t)j * 2097152, (bf16_t*)(ws + WS_WGLU) + (size_t)j * 2097152, 1024, 2048, 1, 1024);
    }
    for (int i = 0; i < 4; ++i) {
        prep_transpose(tl, P.in[22] + (size_t)i * 5767168, (bf16_t*)(ws + WS_WUP) + (size_t)i * 5767168, 1024, 5632, 1, 2816);
        prep_transpose(tl, P.in[23] + (size_t)i * 2883584, (bf16_t*)(ws + WS_WDN) + (size_t)i * 2883584, 2816, 1024, 0, 0);
        prep_transpose(tl, P.in[27] + (size_t)i * 1048576, (bf16_t*)(ws + WS_WPG) + (size_t)i * 1048576, 1024, 1024, 0, 0);
        prep_transpose(tl, P.in[26] + (size_t)i * 262144, (bf16_t*)(ws + WS_WPP) + (size_t)i * 262144, 256, 1024, 0, 0);
    }
    const size_t gt = (size_t)blockIdx.x * 512 + opq(threadIdx.x), gs = (size_t)gridDim.x * 512;
    {
        f32x4* X4 = (f32x4*)(P.out + O_Y); u32x2* XB2 = (u32x2*)(ws + WS_XB);
        const f32x4* xp = (const f32x4*)P.in[0]; const f32x4* xs = (const f32x4*)P.in[1];
        const size_t np4 = (size_t)NPR * D / 4, nt4 = (size_t)NTOK * D / 4;
        for (size_t i = gt; i < nt4; i += gs) { const f32x4 v = (i < np4) ? xp[i] : xs[i - np4]; X4[i] = v; u32x2 w; w.x = pack2(v[0], v[1]); w.y = pack2(v[2], v[3]); XB2[i] = w; }
    }
    {
        u32x2* PB2 = (u32x2*)(ws + WS_PB); const f32x4* pp = (const f32x4*)P.in[5]; const f32x4* ps = (const f32x4*)P.in[6];
        const size_t lp4 = (size_t)NPR * PLED / 4, ls4 = (size_t)1024 * PLED / 4, lt4 = lp4 + ls4;
        for (size_t i = gt; i < 4 * lt4; i += gs) { const size_t l = i / lt4, r = i - l * lt4; const f32x4 v = (r < lp4) ? pp[l * lp4 + r] : ps[l * ls4 + (r - lp4)]; u32x2 w; w.x = pack2(v[0], v[1]); w.y = pack2(v[2], v[3]); PB2[i] = w; }
    }
    if (gt < 1024) { float* LB = (float*)(ws + WS_LB); const float b0 = P.in[8][gt], b1 = P.in[8][1024 + gt]; LB[gt] = 0.f; LB[1024 + gt] = frcp(1.0f + __expf(b0 - b1)); }
    for (int it = blockIdx.x; it < 128; it += gridDim.x) prep_s5(lds, P, it >> 6, it & 63, (bf16_t*)(ws + WS_QT), (bf16_t*)(ws + WS_TPT), (f32x2*)(ws + WS_LAM8));
}

DI void ln_phase(const float* Z, const float* w, const float* b, float* X, bf16_t* XB) {
    const int tid_ = opq(threadIdx.x); const int lane = tid_ & 63; const int wv = blockIdx.x * 8 + (tid_ >> 6), nw = gridDim.x * 8;
    f32x4 wv4[4], bv4[4];
#pragma unroll
    for (int i = 0; i < 4; ++i) { wv4[i] = ((const f32x4*)w)[lane + 64 * i]; bv4[i] = ((const f32x4*)b)[lane + 64 * i]; }
    for (int row = wv; row < NTOK; row += nw) {
        const f32x4* zr = (const f32x4*)(Z + (size_t)row * D); f32x4 v[4]; float s = 0.f;
#pragma unroll
        for (int i = 0; i < 4; ++i) { v[i] = zr[lane + 64 * i]; s += (v[i][0] + v[i][1]) + (v[i][2] + v[i][3]); }
        const float mean = wave_sum(s) * (1.0f / D); float q = 0.f;
#pragma unroll
        for (int i = 0; i < 4; ++i) { v[i] = v[i] - mean; q += (v[i][0] * v[i][0] + v[i][1] * v[i][1]) + (v[i][2] * v[i][2] + v[i][3] * v[i][3]); }
        const float rstd = rsqrtf(wave_sum(q) * (1.0f / D) + LN_EPS);
#pragma unroll
        for (int i = 0; i < 4; ++i) { const f32x4 y = v[i] * rstd * wv4[i] + bv4[i]; ((f32x4*)(X + (size_t)row * D))[lane + 64 * i] = y; u32x2 o; o.x = pack2(y[0], y[1]); o.y = pack2(y[2], y[3]); ((u32x2*)(XB + (size_t)row * D))[lane + 64 * i] = o; }
    }
}
DI void ple_norm_phase(const float* E, const float* w, float* X, bf16_t* XB) {
    const int tid_ = opq(threadIdx.x); const int lane = tid_ & 63; const int wv = blockIdx.x * 8 + (tid_ >> 6), nw = gridDim.x * 8;
    f32x4 wv4[4];
#pragma unroll
    for (int i = 0; i < 4; ++i) wv4[i] = ((const f32x4*)w)[lane + 64 * i];
    for (int row = wv; row < NTOK; row += nw) {
        const f32x4* er = (const f32x4*)(E + (size_t)row * D); f32x4 v[4]; float q = 0.f;
#pragma unroll
        for (int i = 0; i < 4; ++i) { v[i] = er[lane + 64 * i]; q += (v[i][0] * v[i][0] + v[i][1] * v[i][1]) + (v[i][2] * v[i][2] + v[i][3] * v[i][3]); }
        const float rr = rsqrtf(wave_sum(q) * (1.0f / D) + RMS_EPS);
#pragma unroll
        for (int i = 0; i < 4; ++i) { f32x4* xp = (f32x4*)(X + (size_t)row * D) + lane + 64 * i; const f32x4 y = *xp + v[i] * rr * wv4[i]; *xp = y; u32x2 o; o.x = pack2(y[0], y[1]); o.y = pack2(y[2], y[3]); ((u32x2*)(XB + (size_t)row * D))[lane + 64 * i] = o; }
    }
}
DI void hg_post_phase(const float* ORAW, const bf16_t* G, const float* gw, bf16_t* OG) {
    const int tid_ = opq(threadIdx.x); const int lane = tid_ & 63; const int wv = blockIdx.x * 8 + (tid_ >> 6), nw = gridDim.x * 8;
    f32x4 gwv[4];
#pragma unroll
    for (int i = 0; i < 4; ++i) gwv[i] = ((const f32x4*)gw)[(lane & 7) * 4 + i];
    for (int row = wv; row < NTOK; row += nw) {
        const f32x4* orow = (const f32x4*)(ORAW + (size_t)row * D) + lane * 4; f32x4 v[4]; float q = 0.f;
#pragma unroll
        for (int i = 0; i < 4; ++i) { v[i] = orow[i]; q += (v[i][0] * v[i][0] + v[i][1] * v[i][1]) + (v[i][2] * v[i][2] + v[i][3] * v[i][3]); }
        q += __shfl_xor(q, 1); q += __shfl_xor(q, 2); q += __shfl_xor(q, 4);
        const float rr = rsqrtf(q * (1.0f / 128.0f) + RMS_EPS);
        const u32x4* grow = (const u32x4*)(G + (size_t)row * D) + lane * 2; const u32x4 g0 = grow[0], g1 = grow[1];
        const unsigned gu[8] = {g0.x, g0.y, g0.z, g0.w, g1.x, g1.y, g1.z, g1.w};
        u32x4 o0, o1; unsigned ou[8];
#pragma unroll
        for (int i = 0; i < 4; ++i) { const f32x4 y = v[i] * rr * gwv[i]; ou[2 * i] = pack2(y[0] * bf_lo(gu[2 * i]), y[1] * bf_hi(gu[2 * i])); ou[2 * i + 1] = pack2(y[2] * bf_lo(gu[2 * i + 1]), y[3] * bf_hi(gu[2 * i + 1])); }
        o0.x = ou[0]; o0.y = ou[1]; o0.z = ou[2]; o0.w = ou[3]; o1.x = ou[4]; o1.y = ou[5]; o1.z = ou[6]; o1.w = ou[7];
        u32x4* op = (u32x4*)(OG + (size_t)row * D) + lane * 2; op[0] = o0; op[1] = o1;
    }
}

DI void hg_pre_phase(LAS unsigned char* lds, const bf16_t* Q, const float* LF, const bf16_t* V, bf16_t* QE, bf16_t* KDT, bf16_t* ATT, bf16_t* VF, float* DEC) {
    const int tid_ = opq(threadIdx.x); const int lane = tid_ & 63, wid = tid_ >> 6, t = lane & 31, h = lane >> 5;
    LAS bf16_t* vt = (LAS bf16_t*)(lds + wid * 17408);
    LAS bf16_t* kt = vt + 32 * 136;
    for (int item = blockIdx.x * 8 + wid; item < NITEM_HG; item += gridDim.x * 8) {
        const int ci = item >> 3, hd = item & 7;
        const int tb = (ci < 512) ? ci * 32 : NPR + (ci - 512) * 8; const int nv = (ci < 512) ? 32 : 8;
        const bool valid = t < nv; const size_t ro = (size_t)(tb + (valid ? t : 0)) * D + hd * 128;
        f32x16 attT; for (int i = 0; i < 16; ++i) attT[i] = 0.f;
#pragma unroll 1
        for (int j = 0; j < 8; ++j) {
            const int ka = 16 * j + 4 * h;
            f32x4 l0 = *(const f32x4*)(LF + ro + ka), l1 = *(const f32x4*)(LF + ro + ka + 8);
            u32x2 q0 = *(const u32x2*)(Q + ro + ka), q1 = *(const u32x2*)(Q + ro + ka + 8);
            float lf8[8] = {l0[0], l0[1], l0[2], l0[3], l1[0], l1[1], l1[2], l1[3]};
            float q8[8] = {bf_lo(q0.x), bf_hi(q0.x), bf_lo(q0.y), bf_hi(q0.y), bf_lo(q1.x), bf_hi(q1.x), bf_lo(q1.y), bf_hi(q1.y)};
            float qe[8], kd[8], qh[8], kh[8], dc[8];
#pragma unroll
            for (int i = 0; i < 8; ++i) {
                const float lf = valid ? lf8[i] : 0.f; const float qv = valid ? q8[i] : 0.f;
                float b = lf;
#pragma unroll
                for (int d = 1; d < 32; d <<= 1) { const float tmp = __shfl_up(b, d, 32); if (t >= d) b += tmp; }
                const float bl = __shfl(b, 31, 32), bm = __shfl(b, 15, 32);
                const float kk = valid ? 1.0f - __expf(lf) : 0.f;
                qe[i] = qv * __expf(b); kd[i] = kk * __expf(bl - b); qh[i] = qv * __expf(b - bm); kh[i] = kk * __expf(bm - b); dc[i] = __expf(bl);
            }
            *(bf16x8*)(QE + (size_t)item * 4096 + (j * 64 + lane) * 8) = pack8(qe[0], qe[1], qe[2], qe[3], qe[4], qe[5], qe[6], qe[7]);
            const bf16x8 qhf = pack8(qh[0], qh[1], qh[2], qh[3], qh[4], qh[5], qh[6], qh[7]);
            const bf16x8 khf = pack8(kh[0], kh[1], kh[2], kh[3], kh[4], kh[5], kh[6], kh[7]);
            attT = MFMA32(khf, qhf, attT);
            u32x2 k0, k1; k0.x = pack2(kd[0], kd[1]); k0.y = pack2(kd[2], kd[3]); k1.x = pack2(kd[4], kd[5]); k1.y = pack2(kd[6], kd[7]);
            *(LAS u32x2*)(kt + t * 136 + ka) = k0; *(LAS u32x2*)(kt + t * 136 + ka + 8) = k1;
            if (t == 0) { float* dp = DEC + (size_t)item * 128 + ((j >> 1) * 2 + h) * 16 + 8 * (j & 1); *(f32x4*)dp = (f32x4){dc[0], dc[1], dc[2], dc[3]}; *(f32x4*)(dp + 4) = (f32x4){dc[4], dc[5], dc[6], dc[7]}; }
        }
#pragma unroll
        for (int ks = 0; ks < 2; ++ks) {
            float a[8];
#pragma unroll
            for (int i = 0; i < 8; ++i) { const int s = crow(8 * ks + i, h); a[i] = (s <= t) ? attT[8 * ks + i] : 0.f; }
            *(bf16x8*)(ATT + (size_t)item * 1024 + (ks * 64 + lane) * 8) = pack8(a[0], a[1], a[2], a[3], a[4], a[5], a[6], a[7]);
        }
#pragma unroll
        for (int c8 = 0; c8 < 8; ++c8) { u32x4 vv = *(const u32x4*)(V + ro + 64 * h + 8 * c8); if (!valid) vv = (u32x4){0u, 0u, 0u, 0u}; *(LAS u32x4*)(vt + t * 136 + 64 * h + 8 * c8) = vv; }
        asm volatile("s_waitcnt lgkmcnt(0)" ::: "memory"); __builtin_amdgcn_wave_barrier();
#pragma unroll
        for (int vs = 0; vs < 4; ++vs)
#pragma unroll
            for (int ks = 0; ks < 2; ++ks) {
                unsigned short e[8]; unsigned short f[8];
#pragma unroll
                for (int i = 0; i < 8; ++i) { const int s = crow(8 * ks + i, h); e[i] = vt[s * 136 + 32 * vs + t]; f[i] = kt[s * 136 + 32 * vs + t]; }
                u32x4 pv, pk; pv.x = e[0] | ((unsigned)e[1] << 16); pv.y = e[2] | ((unsigned)e[3] << 16); pv.z = e[4] | ((unsigned)e[5] << 16); pv.w = e[6] | ((unsigned)e[7] << 16);
                pk.x = f[0] | ((unsigned)f[1] << 16); pk.y = f[2] | ((unsigned)f[3] << 16); pk.z = f[4] | ((unsigned)f[5] << 16); pk.w = f[6] | ((unsigned)f[7] << 16);
                *(u32x4*)(VF + (size_t)item * 4096 + ((vs * 2 + ks) * 64 + lane) * 8) = pv;
                *(u32x4*)(KDT + (size_t)item * 4096 + ((vs * 2 + ks) * 64 + lane) * 8) = pk;
            }
        asm volatile("s_waitcnt lgkmcnt(0)" ::: "memory"); __builtin_amdgcn_wave_barrier();
    }
}

DI void hg_scan_item(int ci0, int nch, int hd, int vs, const float* S0, float* Sout, const bf16_t* QE, const bf16_t* KDT, const bf16_t* ATT, const bf16_t* VF, const float* DEC, float* ORAW) {
    const int lane = opq(threadIdx.x) & 63, c = lane & 31, h = lane >> 5;
    f32x16 S[4];
#pragma unroll
    for (int kb = 0; kb < 4; ++kb)
#pragma unroll
        for (int r = 0; r < 16; ++r) S[kb][r] = S0 ? S0[(size_t)(32 * kb + crow(r, h)) * 128 + 32 * vs + c] : 0.f;
#pragma unroll 1
    for (int cc = 0; cc < nch; ++cc) {
        const int ci = ci0 + cc; const int item = ci * 8 + hd;
        const int tb = (ci < 512) ? ci * 32 : NPR + (ci - 512) * 8; const int nv = (ci < 512) ? 32 : 8;
        const bf16x8* qe = (const bf16x8*)(QE + (size_t)item * 4096) + lane;
        const bf16x8* kdt = (const bf16x8*)(KDT + (size_t)item * 4096) + lane;
        const bf16x8* att = (const bf16x8*)(ATT + (size_t)item * 1024) + lane;
        const bf16x8* vf = (const bf16x8*)(VF + (size_t)item * 4096) + (vs * 2) * 64 + lane;
        const f32x4* dec = (const f32x4*)(DEC + (size_t)item * 128);
        const bf16x8 a0 = att[0], a1 = att[64], v0 = vf[0], v1 = vf[64];
        f32x16 o; for (int i = 0; i < 16; ++i) o[i] = 0.f;
        o = MFMA32(a0, v0, o); o = MFMA32(a1, v1, o);
#pragma unroll
        for (int kb = 0; kb < 4; ++kb) {
            const bf16x8 q0 = qe[(2 * kb) * 64], q1 = qe[(2 * kb + 1) * 64];
            const bf16x8 s0 = pack8(S[kb][0], S[kb][1], S[kb][2], S[kb][3], S[kb][4], S[kb][5], S[kb][6], S[kb][7]);
            const bf16x8 s1 = pack8(S[kb][8], S[kb][9], S[kb][10], S[kb][11], S[kb][12], S[kb][13], S[kb][14], S[kb][15]);
            o = MFMA32(q0, s0, o); o = MFMA32(q1, s1, o);
        }
#pragma unroll
        for (int r = 0; r < 16; ++r) { const int tt = crow(r, h); if (tt < nv) ORAW[(size_t)(tb + tt) * D + hd * 128 + 32 * vs + c] = o[r]; }
#pragma unroll
        for (int kb = 0; kb < 4; ++kb) {
            const bf16x8 k0 = kdt[(kb * 2) * 64], k1 = kdt[(kb * 2 + 1) * 64];
            const f32x4 d0 = dec[(kb * 2 + h) * 4], d1 = dec[(kb * 2 + h) * 4 + 1], d2 = dec[(kb * 2 + h) * 4 + 2], d3 = dec[(kb * 2 + h) * 4 + 3];
#pragma unroll
            for (int r = 0; r < 4; ++r) { S[kb][r] *= d0[r]; S[kb][4 + r] *= d1[r]; S[kb][8 + r] *= d2[r]; S[kb][12 + r] *= d3[r]; }
            S[kb] = MFMA32(k0, v0, S[kb]); S[kb] = MFMA32(k1, v1, S[kb]);
        }
    }
#pragma unroll
    for (int kb = 0; kb < 4; ++kb)
#pragma unroll
        for (int r = 0; r < 16; ++r) Sout[(size_t)(32 * kb + crow(r, h)) * 128 + 32 * vs + c] = S[kb][r];
}
DI void hg_scan_phase(const Params& P, int j, const bf16_t* QE, const bf16_t* KDT, const bf16_t* ATT, const bf16_t* VF, const float* DEC, float* ORAW) {
    const int wid = opq(threadIdx.x) >> 6; const int G = gridDim.x; const int bx = blockIdx.x;
    int fw, nfree;
    if (G >= 64) { nfree = 256 + (G - 64) * 8; fw = (bx < 64) ? ((wid >= 4) ? bx * 4 + wid - 4 : -1) : 256 + (bx - 64) * 8 + wid; }
    else { nfree = G * 4; fw = (wid >= 4) ? bx * 4 + wid - 4 : -1; }
    if (wid < 4) {
        for (int bh = bx; bh < 64; bh += G) {
            if (G >= 64 && bx >= 64) break;
            const int b = bh >> 3, hd = bh & 7;
            hg_scan_item(b * 64, 64, hd, wid, nullptr, P.out + O_HGP + ((size_t)(j * 8 + b) * 8 + hd) * 16384, QE, KDT, ATT, VF, DEC, ORAW);
        }
    }
    if (fw >= 0) {
        for (int sid = fw; sid < 4096; sid += nfree) {
            const int vs = sid & 3, sh = sid >> 2, sb = sh >> 3, hd = sh & 7;
            const size_t so = ((size_t)(j * 128 + sb) * 8 + hd) * 16384;
            hg_scan_item(512 + sb, 1, hd, vs, P.in[2] + so, P.out + O_HGS + so, QE, KDT, ATT, VF, DEC, ORAW);
        }
    }
}

template <int MODE>
DI void s5_mm_phase(LAS unsigned char* lds, const bf16_t* XB, const bf16_t* HPREV, const bf16_t* Wt, float* E, bf16_t* YB) {
    constexpr int K = MODE ? 256 : 128, LDK = K + 8;
    LAS bf16_t* As = (LAS bf16_t*)lds; LAS bf16_t* Bs = As + 128 * LDK;
    const int tid = opq(threadIdx.x), lane = tid & 63, wid = tid >> 6, c = lane & 31, h = lane >> 5, wr2 = wid >> 1, wc2 = wid & 1;
    for (int item = blockIdx.x; item < 64 * 17; item += gridDim.x) {
        const int g = item & 63, rt = item >> 6;
        __syncthreads();
        {
            const int r = tid >> 2, q = tid & 3; const int cr = rt * 128 + r;
#pragma unroll
            for (int jj = 0; jj < 2; ++jj) { const int j = 2 * q + jj; const u32x4* src = (const u32x4*)(XB + (size_t)(cr * 8 + j) * D + g * 16); const u32x4 x0 = src[0], x1 = src[1];
                *(LAS u32x4*)(As + r * LDK + j * 16) = x0; *(LAS u32x4*)(As + r * LDK + j * 16 + 8) = x1; }
            if (MODE) { const u32x4* src = (const u32x4*)(HPREV + ((size_t)cr * 64 + g) * 128 + q * 32);
#pragma unroll
                for (int i = 0; i < 4; ++i) *(LAS u32x4*)(As + r * LDK + 128 + q * 32 + i * 8) = src[i]; }
            const u32x4* sb = (const u32x4*)(Wt + ((size_t)g * 128 + r) * K + q * (K / 4));
#pragma unroll
            for (int i = 0; i < K / 32; ++i) *(LAS u32x4*)(Bs + r * LDK + q * (K / 4) + i * 8) = sb[i];
        }
        __syncthreads();
        f32x16 acc0, acc1; for (int i = 0; i < 16; ++i) { acc0[i] = 0.f; acc1[i] = 0.f; }
#pragma unroll
        for (int ks = 0; ks < K / 16; ++ks) {
            const bf16x8 a = *(const LAS bf16x8*)(As + (32 * wr2 + c) * LDK + 16 * ks + 8 * h);
            const bf16x8 b0 = *(const LAS bf16x8*)(Bs + (64 * wc2 + c) * LDK + 16 * ks + 8 * h);
            const bf16x8 b1 = *(const LAS bf16x8*)(Bs + (64 * wc2 + 32 + c) * LDK + 16 * ks + 8 * h);
            acc0 = MFMA32(a, b0, acc0); acc1 = MFMA32(a, b1, acc1);
        }
#pragma unroll
        for (int r = 0; r < 16; ++r) {
            const int cr = rt * 128 + 32 * wr2 + crow(r, h);
            if (MODE == 0) { float* ep = E + ((size_t)cr * 64 + g) * 128 + 64 * wc2 + c; ep[0] = acc0[r]; ep[32] = acc1[r]; }
            else {
                const int n0 = 64 * wc2 + c, n1 = n0 + 32;
                YB[(size_t)(cr * 8 + (n0 >> 4)) * D + g * 16 + (n0 & 15)] = (bf16_t)pack2(gelu_tanh(acc0[r]), 0.f);
                YB[(size_t)(cr * 8 + (n1 >> 4)) * D + g * 16 + (n1 & 15)] = (bf16_t)pack2(gelu_tanh(acc1[r]), 0.f);
            }
        }
    }
}
DI void s5_scan_phase(const Params& P, int j, const float* E, bf16_t* HPREV, const f32x2* LAM8) {
    const f32x2* E2 = (const f32x2*)E; unsigned* HP = (unsigned*)HPREV; const f32x2* lam = LAM8 + (size_t)j * 4096;
    const int tid = opq(threadIdx.x);
    for (size_t id = (size_t)blockIdx.x * 512 + tid; id < (size_t)128 * 4096; id += (size_t)gridDim.x * 512) {
        const int sb = (int)(id >> 12), gp = (int)(id & 4095); const size_t ix = (size_t)(2048 + sb) * 4096 + gp;
        const float hr = P.in[3][(size_t)j * 524288 + id], hi = P.in[4][(size_t)j * 524288 + id]; const f32x2 l = lam[gp], ev = E2[ix];
        HP[ix] = pack2(hr, hi);
        P.out[O_RES + (size_t)j * 524288 + id] = l.x * hr - l.y * hi + ev.x; P.out[O_IMS + (size_t)j * 524288 + id] = l.x * hi + l.y * hr + ev.y;
    }
    if (tid < 128) {
        for (int chain = blockIdx.x * 128 + tid; chain < 32768; chain += gridDim.x * 128) {
            const int b = chain >> 12, gp = chain & 4095; const f32x2 l = lam[gp]; float hr = 0.f, hi = 0.f;
            for (int c0 = 0; c0 < 256; c0 += 8) {
                f32x2 ev[8];
#pragma unroll
                for (int i = 0; i < 8; ++i) ev[i] = E2[(size_t)(b * 256 + c0 + i) * 4096 + gp];
#pragma unroll
                for (int i = 0; i < 8; ++i) { HP[(size_t)(b * 256 + c0 + i) * 4096 + gp] = pack2(hr, hi); const float nr = l.x * hr - l.y * hi + ev[i].x, ni = l.x * hi + l.y * hr + ev[i].y; hr = nr; hi = ni; }
            }
            P.out[O_REP + (size_t)j * 32768 + chain] = hr; P.out[O_IMP + (size_t)j * 32768 + chain] = hi;
        }
    }
}

__global__ void __launch_bounds__(512, 2) fwd_megakernel(Params P) {
    extern __shared__ __attribute__((aligned(16))) unsigned char lds_raw[];
    LAS unsigned char* lds = (LAS unsigned char*)lds_raw;
    cg::grid_group grid = cg::this_grid();
    unsigned char* ws = P.ws; unsigned char* U = ws + WS_U;
    float* X = P.out + O_Y; bf16_t* XB = (bf16_t*)(ws + WS_XB); float* Z = (float*)(U + U_Z);
    const int G = gridDim.x, bx = blockIdx.x;

    prep_phase(lds, P);
    grid.sync();

#pragma unroll 1
    for (int layer_ = 0; layer_ < 4; ++layer_) {
        const int layer = opqs(layer_); const int j = layer >> 1;
        if ((layer & 1) == 0) {
            bf16_t* Qb = (bf16_t*)(U + U_Q); float* LF = (float*)(U + U_LF); bf16_t* Vb = (bf16_t*)(U + U_V); bf16_t* Gb = (bf16_t*)(U + U_G);
            bf16_t* QE = (bf16_t*)(U + U_QE); bf16_t* KDT = (bf16_t*)(U + U_KDT); bf16_t* ATT = (bf16_t*)(U + U_ATT); bf16_t* VF = (bf16_t*)(U + U_VF); float* DEC = (float*)(U + U_DEC);
            { pg8::Gemm g{XB, (const bf16_t*)(ws + WS_WIN) + (size_t)j * 4194304, NTOK, 4096, 1024}; pg8::StaticOrder S; S.init(NTOK, 4096, G, bx);
              EpiWin E{Qb, LF, Vb, Gb, (const float*)(ws + WS_LB) + j * 1024}; pg8::gemm_phase(lds, g, S, E); }
            grid.sync();
            hg_pre_phase(lds, Qb, LF, Vb, QE, KDT, ATT, VF, DEC);
            grid.sync();
            hg_scan_phase(P, j, QE, KDT, ATT, VF, DEC, LF  );
            grid.sync();
            hg_post_phase(LF, Gb, P.in[9] + j * 128, Qb  );
            grid.sync();
            { pg8::Gemm g{Qb, (const bf16_t*)(ws + WS_WOUT) + (size_t)j * 1048576, NTOK, 1024, 1024}; pg8::StaticOrder S; S.init(NTOK, 1024, G, bx);
              EpiRes E{X, Z}; pg8::gemm_phase(lds, g, S, E); }
            grid.sync();
        } else {
            float* Eb = (float*)(U + U_E); bf16_t* HPREV = (bf16_t*)(U + U_HPREV); bf16_t* YB = (bf16_t*)(U + U_YB);
            s5_mm_phase<0>(lds, XB, nullptr, (const bf16_t*)(ws + WS_QT) + (size_t)j * 1048576, Eb, nullptr);
            grid.sync();
            s5_scan_phase(P, j, Eb, HPREV, (const f32x2*)(ws + WS_LAM8));
            grid.sync();
            s5_mm_phase<1>(lds, XB, HPREV, (const bf16_t*)(ws + WS_TPT) + (size_t)j * 2097152, nullptr, YB);
            grid.sync();
            { pg8::Gemm g{YB, (const bf16_t*)(ws + WS_WGLU) + (size_t)j * 2097152, NTOK, 2048, 1024}; pg8::StaticOrder S; S.init(NTOK, 2048, G, bx);
              EpiGlu E{X, Z}; pg8::gemm_phase(lds, g, S, E); }
            grid.sync();
        }
        ln_phase(Z, P.in[20] + layer * D, P.in[21] + layer * D, X, XB);
        grid.sync();
        bf16_t* Hb = (bf16_t*)(U + U_H);
        { pg8::Gemm g{XB, (const bf16_t*)(ws + WS_WUP) + (size_t)layer * 5767168, NTOK, 5632, 1024}; pg8::StaticOrder S; S.init(NTOK, 5632, G, bx);
          EpiSwi E{Hb}; pg8::gemm_phase(lds, g, S, E); }
        grid.sync();
        { pg8::Gemm g{Hb, (const bf16_t*)(ws + WS_WDN) + (size_t)layer * 2883584, NTOK, 1024, DFF}; pg8::StaticOrder S; S.init(NTOK, 1024, G, bx);
          EpiRes E{X, Z}; pg8::gemm_phase(lds, g, S, E); }
        grid.sync();
        ln_phase(Z, P.in[24] + layer * D, P.in[25] + layer * D, X, XB);
        grid.sync();
        float* Pe = (float*)(U + U_P);
        { pg8::Gemm g{(const bf16_t*)(ws + WS_PB) + (size_t)layer * NTOK * PLED, (const bf16_t*)(ws + WS_WPP) + (size_t)layer * 262144, NTOK, 1024, PLED}; pg8::StaticOrder S; S.init(NTOK, 1024, G, bx);
          EpiF32 E{Pe}; pg8::gemm_phase(lds, g, S, E); }
        { pg8::Gemm g{XB, (const bf16_t*)(ws + WS_WPG) + (size_t)layer * 1048576, NTOK, 1024, 1024}; pg8::StaticOrder S; S.init(NTOK, 1024, G, bx);
          EpiPleGate E{Pe}; pg8::gemm_phase(lds, g, S, E); }
        grid.sync();
        ple_norm_phase(Pe, P.in[28] + layer * D, X, XB);
        grid.sync();
    }
}

extern "C" void kernel_launch(void* const* d_in, const int* in_sizes, int n_in, void* d_out, int out_size, void* d_ws, size_t ws_size, hipStream_t stream) {
    static int grid_blocks = 0;
    if (grid_blocks == 0) {
        int dev = 0, cus = 0, per_cu = 0;
        hipGetDevice(&dev);
        hipDeviceGetAttribute(&cus, hipDeviceAttributeMultiprocessorCount, dev);
        if (hipFuncSetAttribute((const void*)fwd_megakernel, hipFuncAttributeMaxDynamicSharedMemorySize, LDS_BYTES) != hipSuccess) { fprintf(stderr, "hipFuncSetAttribute failed\n"); grid_blocks = -1; return; }
        if (hipOccupancyMaxActiveBlocksPerMultiprocessor(&per_cu, (const void*)fwd_megakernel, 512, LDS_BYTES) != hipSuccess || per_cu < 1) { fprintf(stderr, "occupancy query failed (%d)\n", per_cu); (void)hipGetLastError(); per_cu = 1; }
        grid_blocks = cus * 1;
        if (ws_size < WS_END) { fprintf(stderr, "workspace too small: %zu < %zu\n", ws_size, (size_t)WS_END); grid_blocks = -1; return; }
    }
    if (grid_blocks < 0) return;
    Params p{};
    for (int i = 0; i < 29; ++i) p.in[i] = (const float*)d_in[i];
    p.out = (float*)d_out; p.ws = (unsigned char*)d_ws;
    void* args[] = {&p};
    hipError_t e = hipLaunchCooperativeKernel((const void*)fwd_megakernel, dim3(grid_blocks), dim3(512), args, LDS_BYTES, stream);
    if (e != hipSuccess) fprintf(stderr, "cooperative launch failed: %s (grid %d)\n", hipGetErrorString(e), grid_blocks);
}
```

```cpp
#include <hip/hip_runtime.h>
#include <hip/hip_cooperative_groups.h>
#include <cstdio>
namespace cg = cooperative_groups;

#define LAS __attribute__((address_space(3)))
typedef unsigned short bf16_t;
typedef short bf16x8 __attribute__((ext_vector_type(8)));
typedef float f32x4 __attribute__((ext_vector_type(4)));
typedef float f32x2 __attribute__((ext_vector_type(2)));
typedef float f32x16 __attribute__((ext_vector_type(16)));
typedef unsigned u32x4 __attribute__((ext_vector_type(4)));
typedef unsigned u32x2 __attribute__((ext_vector_type(2)));
typedef __bf16 bf2_t __attribute__((ext_vector_type(2)));
#define DI __device__ __forceinline__

constexpr int D = 1024, NTOK = 17408, NPR = 16384;
constexpr int DFF = 2816, PLED = 256;
constexpr float ALPHA = 1.681792830507429f;
constexpr float QK_SCALE = 0.08838834764831845f;
constexpr float LN_EPS = 1e-5f, RMS_EPS = 1e-6f;
constexpr int LDS_BYTES = 139264 + 16;
constexpr int NITEM_HG = 5120;

constexpr size_t WS_WIN = 0;
constexpr size_t WS_WOUT = WS_WIN + 16777216;
constexpr size_t WS_WGLU = WS_WOUT + 4194304;
constexpr size_t WS_WUP = WS_WGLU + 8388608;
constexpr size_t WS_WDN = WS_WUP + 46137344;
constexpr size_t WS_WPG = WS_WDN + 23068672;
constexpr size_t WS_WPP = WS_WPG + 8388608;
constexpr size_t WS_QT = WS_WPP + 2097152;
constexpr size_t WS_TPT = WS_QT + 4194304;
constexpr size_t WS_LAM8 = WS_TPT + 8388608;
constexpr size_t WS_LB = WS_LAM8 + 65536;
constexpr size_t WS_PB = WS_LB + 8192;
constexpr size_t WS_XB = WS_PB + 35651584;
constexpr size_t WS_U = WS_XB + 35651584;
constexpr size_t U_Q = 0, U_LF = 35651584, U_V = 106954752, U_G = 142606336, U_FR = 178257920;
constexpr size_t U_QE = U_FR, U_KDT = U_QE + (size_t)NITEM_HG * 8192, U_ATT = U_KDT + (size_t)NITEM_HG * 8192, U_VF = U_ATT + (size_t)NITEM_HG * 2048, U_DEC = U_VF + (size_t)NITEM_HG * 8192;
constexpr size_t U_Z = 178257920;
constexpr size_t U_H = 0, U_P = 0, U_E = 0, U_HPREV = 71303168, U_YB = 106954752;
constexpr size_t WS_BAR = WS_U + U_DEC + (size_t)NITEM_HG * 512;
constexpr size_t WS_END = WS_BAR + 16384;

constexpr size_t O_Y = 0, O_HGP = 17825792, O_REP = 19922944, O_IMP = 19988480, O_HGS = 20054016, O_RES = 53608448, O_IMS = 54657024;

struct Params { const float* in[29]; float* out; unsigned char* ws; };

DI unsigned pack2(float lo, float hi) { f32x2 v = {lo, hi}; bf2_t b = __builtin_convertvector(v, bf2_t); return __builtin_bit_cast(unsigned, b); }
DI float bf_lo(unsigned u) { return __uint_as_float(u << 16); }
DI float bf_hi(unsigned u) { return __uint_as_float(u & 0xffff0000u); }
DI float frcp(float x) { return __builtin_amdgcn_rcpf(x); }
DI float sigm(float x) { return frcp(1.0f + __expf(-x)); }
DI float silu(float x) { return x * sigm(x); }
DI float gelu_tanh(float y) { const float u = 0.7978845608028654f * (y + 0.044715f * y * y * y); const float t = 1.0f - 2.0f * frcp(__expf(2.0f * u) + 1.0f); return 0.5f * y * (1.0f + t); }
DI float wave_sum(float v) { for (int o = 32; o >= 1; o >>= 1) v += __shfl_xor(v, o); return v; }
DI int opq(int x) { asm volatile("" : "+v"(x)); return x; }
DI int opqs(int x) { asm volatile("" : "+s"(x)); return x; }
DI int crow(int reg, int h) { return (reg & 3) + 8 * (reg >> 2) + 4 * h; }
#define MFMA32(a, b, c) __builtin_amdgcn_mfma_f32_32x32x16_bf16((a), (b), (c), 0, 0, 0)
DI bf16x8 pack8(float a0, float a1, float a2, float a3, float a4, float a5, float a6, float a7) {
    u32x4 p; p.x = pack2(a0, a1); p.y = pack2(a2, a3); p.z = pack2(a4, a5); p.w = pack2(a6, a7); return __builtin_bit_cast(bf16x8, p);
}

namespace pg8 {
constexpr int BM = 256, BK = 64, HALF = 128, HTB = HALF * BK * 2, NXCD = 8, WGM = 8;
DI int lds_byte(int r, int c) { const int st = (r >> 4) * 2 + (c >> 5), rr = r & 15, cc = c & 31, ob = rr * 64 + cc * 2; return st * 1024 + (ob ^ (((ob >> 9) & 1) << 5)); }
DI void stage_rc(int b, int& R, int& C) { const int st = b / 1024, sb = b % 1024, swz = sb ^ (((sb >> 9) & 1) << 5); R = (st >> 1) * 16 + swz / 64; C = (st & 1) * 32 + (swz % 64) / 2; }
struct Unit { int pm, pn; };
struct Gemm { const bf16_t* A; const bf16_t* Bt; int M, N, K; };
struct StaticOrder {
    int nM, nN, nwg, G, c;
    DI void init(int M, int N, int G_, int c_) { nM = M / BM; nN = N / BM; nwg = nM * nN; G = G_; c = c_; }
    DI bool next(int i, Unit& u) const {
        const long L = (long)i * G + c; if (L >= nwg) return false;
        int wgid = (int)L; { const int q = nwg / NXCD, r = nwg % NXCD, xcd = wgid % NXCD, off = wgid / NXCD; wgid = (xcd < r ? xcd * (q + 1) : r * (q + 1) + (xcd - r) * q) + off; }
        const int nig = WGM * nN, gid = wgid / nig, fm = gid * WGM, gsz = (nM - fm) < WGM ? (nM - fm) : WGM;
        u.pm = fm + ((wgid % nig) % gsz); u.pn = (wgid % nig) / gsz; return true;
    }
};

template <class Epi>
DI void gemm_phase(LAS unsigned char* lds, const Gemm g, const StaticOrder& S, const Epi& E) {
    const int tid = opq(threadIdx.x), wid = __builtin_amdgcn_readfirstlane(tid >> 6), lane = tid & 63, wr = wid >> 2, wc = wid & 3, fr = lane & 15, fq = lane >> 4;
    const int K = g.K, nt = K / BK;
    unsigned voffA[2];
#pragma unroll
    for (int i = 0; i < 2; ++i) { int R, C; stage_rc(tid * 16 + i * 8192, R, C); voffA[i] = (unsigned)(R * K + C) * 2u; }
    const size_t kstep = (size_t)(BK * 2);
    const size_t hstep = (size_t)HALF * K * 2;
    const size_t tstep = 2 * hstep;
    const unsigned ldsw = (unsigned)wid * 1024u;
    const int aoff = lds_byte(wr * 64 + fr, fq * 8), boff = lds_byte(wc * 32 + fr, fq * 8);
#define PG8_SA(b, h) (((b) * 2 + (h)) * HTB)
#define PG8_SB(b, h) ((4 + (b) * 2 + (h)) * HTB)
#define PG8_STAGE(bufoff, gbase) do { _Pragma("unroll") for (int _i = 0; _i < 2; ++_i) \
        __builtin_amdgcn_global_load_lds((const unsigned*)((const char*)(gbase) + voffA[_i]), (LAS unsigned*)(lds + (bufoff) + ldsw + _i * 8192), 16, 0, 0); } while (0)
#define PG8_LDA(dst, b, h) do { _Pragma("unroll") for (int m = 0; m < 4; ++m) _Pragma("unroll") for (int k = 0; k < 2; ++k) dst[m][k] = *(const LAS bf16x8*)(lds + PG8_SA(b, h) + aoff + m * 2048 + k * 1024); } while (0)
#define PG8_LDB(dst, b, h) do { _Pragma("unroll") for (int n = 0; n < 2; ++n) _Pragma("unroll") for (int k = 0; k < 2; ++k) dst[n][k] = *(const LAS bf16x8*)(lds + PG8_SB(b, h) + boff + n * 2048 + k * 1024); } while (0)
#define PG8_MMA(ai, bj, At, Bt) do { __builtin_amdgcn_s_setprio(1); _Pragma("unroll") for (int m = 0; m < 4; ++m) _Pragma("unroll") for (int n = 0; n < 2; ++n) _Pragma("unroll") for (int k = 0; k < 2; ++k) \
        acc[ai][bj][m][n] = __builtin_amdgcn_mfma_f32_16x16x32_bf16(Bt[n][k], At[m][k], acc[ai][bj][m][n], 0, 0, 0); __builtin_amdgcn_s_setprio(0); } while (0)
#define PG8_WAIT_V(n) asm volatile("s_waitcnt vmcnt(" #n ")" ::: "memory")
#define PG8_WAIT_L(n) asm volatile("s_waitcnt lgkmcnt(" #n ")" ::: "memory")
#define PG8_BAR __builtin_amdgcn_s_barrier()
#define PG8_SCHED __builtin_amdgcn_sched_barrier(0)
    Unit cur, nxt; int ui = 0;
    if (!S.next(0, cur)) return;
    f32x4 acc[2][2][4][2];
#pragma unroll
    for (int a = 0; a < 2; ++a)
#pragma unroll
        for (int b = 0; b < 2; ++b)
#pragma unroll
            for (int m = 0; m < 4; ++m)
#pragma unroll
                for (int n = 0; n < 2; ++n) acc[a][b][m][n] = (f32x4){0.f, 0.f, 0.f, 0.f};
    bf16x8 At[4][2], B0[2][2], B1[2][2];
    const char* cA = (const char*)g.A + (size_t)cur.pm * tstep; const char* cB = (const char*)g.Bt + (size_t)cur.pn * tstep;
    PG8_STAGE(PG8_SB(0, 0), cB); PG8_STAGE(PG8_SA(0, 0), cA); PG8_STAGE(PG8_SB(0, 1), cB + hstep); PG8_STAGE(PG8_SA(0, 1), cA + hstep);
    if (wr == 1) PG8_BAR;
    PG8_WAIT_V(4); PG8_BAR;
    PG8_STAGE(PG8_SB(1, 0), cB + kstep); PG8_STAGE(PG8_SA(1, 0), cA + kstep); PG8_STAGE(PG8_SB(1, 1), cB + hstep + kstep);
    PG8_WAIT_V(6); PG8_BAR;
    for (;;) {
        const bool has_next = S.next(ui + 1, nxt);
        const char* nA = has_next ? (const char*)g.A + (size_t)nxt.pm * tstep : cA; const char* nB = has_next ? (const char*)g.Bt + (size_t)nxt.pn * tstep : cB;
        for (int t = 0; t < nt; t += 2) {
            const bool last = (t == nt - 2);
            const char* a1 = cA + (size_t)(t + 1) * kstep;
            const char* a2 = last ? nA : cA + (size_t)(t + 2) * kstep; const char* b2 = last ? nB : cB + (size_t)(t + 2) * kstep;
            const char* a3 = a2 + kstep; const char* b3 = b2 + kstep;
            PG8_LDB(B0, 0, 0); PG8_SCHED; PG8_LDA(At, 0, 0); PG8_STAGE(PG8_SA(1, 1), a1 + hstep);
            PG8_WAIT_L(8); PG8_BAR; PG8_WAIT_L(0); PG8_MMA(0, 0, At, B0); PG8_BAR; PG8_SCHED;
            PG8_LDB(B1, 0, 1); PG8_STAGE(PG8_SB(0, 0), b2);
            PG8_BAR; PG8_WAIT_L(0); PG8_MMA(0, 1, At, B1); PG8_BAR;
            PG8_LDA(At, 0, 1); PG8_STAGE(PG8_SA(0, 0), a2);
            PG8_BAR; PG8_WAIT_L(0); PG8_MMA(1, 0, At, B0); PG8_BAR; PG8_SCHED;
            PG8_STAGE(PG8_SB(0, 1), b2 + hstep);
            PG8_WAIT_V(6); PG8_BAR; PG8_MMA(1, 1, At, B1); PG8_BAR;
            PG8_LDB(B0, 1, 0); PG8_SCHED; PG8_LDA(At, 1, 0); PG8_STAGE(PG8_SA(0, 1), a2 + hstep);
            PG8_WAIT_L(8); PG8_BAR; PG8_WAIT_L(0); PG8_MMA(0, 0, At, B0); PG8_BAR; PG8_SCHED;
            PG8_LDB(B1, 1, 1); PG8_STAGE(PG8_SB(1, 0), b3);
            PG8_BAR; PG8_WAIT_L(0); PG8_MMA(0, 1, At, B1); PG8_BAR;
            PG8_LDA(At, 1, 1); PG8_STAGE(PG8_SA(1, 0), a3);
            PG8_BAR; PG8_WAIT_L(0); PG8_MMA(1, 0, At, B0); PG8_BAR; PG8_SCHED;
            PG8_STAGE(PG8_SB(1, 1), b3 + hstep);
            PG8_WAIT_V(6); PG8_BAR; PG8_MMA(1, 1, At, B1); PG8_BAR;
        }
        E(acc, cur, wr, wc, fr, fq);
        if (!has_next) break;
#pragma unroll
        for (int a = 0; a < 2; ++a)
#pragma unroll
            for (int b = 0; b < 2; ++b)
#pragma unroll
                for (int m = 0; m < 4; ++m)
#pragma unroll
                    for (int n = 0; n < 2; ++n) acc[a][b][m][n] = (f32x4){0.f, 0.f, 0.f, 0.f};
        cur = nxt; cA = nA; cB = nB; ++ui;
    }
    PG8_WAIT_V(0);
    if (wr == 0) PG8_BAR;
    PG8_BAR;
#undef PG8_SA
#undef PG8_SB
#undef PG8_STAGE
#undef PG8_LDA
#undef PG8_LDB
#undef PG8_MMA
#undef PG8_WAIT_V
#undef PG8_WAIT_L
#undef PG8_BAR
#undef PG8_SCHED
}
}
using pg8::Unit;
typedef const f32x4 (&AccRef)[2][2][4][2];

DI void st_bf4(bf16_t* p, f32x4 v) { u32x2 w; w.x = pack2(v[0], v[1]); w.y = pack2(v[2], v[3]); *(u32x2*)p = w; }

struct EpiWin {
    bf16_t* Q; float* LF; bf16_t* V; bf16_t* G; const float* lb;
    DI void operator()(AccRef acc, const Unit& u, int wr, int wc, int fr, int fq) const {
        const int sec = u.pn >> 2;
        const int row0 = u.pm * 256 + wr * 64 + fr, col0 = (u.pn & 3) * 256 + wc * 32 + 4 * fq;
#pragma unroll
        for (int ai = 0; ai < 2; ++ai)
#pragma unroll
            for (int m = 0; m < 4; ++m) {
                const size_t ro = (size_t)(row0 + ai * 128 + m * 16) * D;
#pragma unroll
                for (int bj = 0; bj < 2; ++bj)
#pragma unroll
                    for (int n = 0; n < 2; ++n) {
                        const int col = col0 + bj * 128 + n * 16; const f32x4 a = acc[ai][bj][m][n]; f32x4 o;
                        if (sec == 0) { for (int j = 0; j < 4; ++j) o[j] = silu(a[j]) * QK_SCALE; st_bf4(Q + ro + col, o); }
                        else if (sec == 1) { const f32x4 l = *(const f32x4*)(lb + col); for (int j = 0; j < 4; ++j) o[j] = __logf(l[j] + (1.0f - l[j]) * sigm(a[j])); *(f32x4*)(LF + ro + col) = o; }
                        else if (sec == 2) { st_bf4(V + ro + col, a); }
                        else { for (int j = 0; j < 4; ++j) o[j] = silu(a[j]); st_bf4(G + ro + col, o); }
                    }
            }
    }
};
struct EpiRes {
    const float* X; float* Z;
    DI void operator()(AccRef acc, const Unit& u, int wr, int wc, int fr, int fq) const {
        const int row0 = u.pm * 256 + wr * 64 + fr, col0 = u.pn * 256 + wc * 32 + 4 * fq;
#pragma unroll
        for (int ai = 0; ai < 2; ++ai)
#pragma unroll
            for (int m = 0; m < 4; ++m) {
                const size_t ro = (size_t)(row0 + ai * 128 + m * 16) * D + col0;
#pragma unroll
                for (int bj = 0; bj < 2; ++bj)
#pragma unroll
                    for (int n = 0; n < 2; ++n) { const f32x4 x = *(const f32x4*)(X + ro + bj * 128 + n * 16); *(f32x4*)(Z + ro + bj * 128 + n * 16) = x * ALPHA + acc[ai][bj][m][n]; }
                asm volatile("" ::: "memory");
            }
    }
};
struct EpiGlu {
    const float* X; float* Z;
    DI void operator()(AccRef acc, const Unit& u, int wr, int wc, int fr, int fq) const {
        const int row0 = u.pm * 256 + wr * 64 + fr, col0 = u.pn * 128 + wc * 32 + 4 * fq;
#pragma unroll
        for (int ai = 0; ai < 2; ++ai)
#pragma unroll
            for (int m = 0; m < 4; ++m) {
                const size_t ro = (size_t)(row0 + ai * 128 + m * 16) * D + col0;
#pragma unroll
                for (int n = 0; n < 2; ++n) { const f32x4 x = *(const f32x4*)(X + ro + n * 16); const f32x4 v = acc[ai][0][m][n], gt = acc[ai][1][m][n]; f32x4 o;
                    for (int j = 0; j < 4; ++j) o[j] = x[j] * ALPHA + v[j] * sigm(gt[j]); *(f32x4*)(Z + ro + n * 16) = o; }
            }
    }
};
struct EpiSwi {
    bf16_t* H;
    DI void operator()(AccRef acc, const Unit& u, int wr, int wc, int fr, int fq) const {
        const int row0 = u.pm * 256 + wr * 64 + fr, col0 = u.pn * 128 + wc * 32 + 4 * fq;
#pragma unroll
        for (int ai = 0; ai < 2; ++ai)
#pragma unroll
            for (int m = 0; m < 4; ++m) {
                const size_t ro = (size_t)(row0 + ai * 128 + m * 16) * DFF + col0;
#pragma unroll
                for (int n = 0; n < 2; ++n) { const f32x4 gt = acc[ai][0][m][n], up = acc[ai][1][m][n]; f32x4 o; for (int j = 0; j < 4; ++j) o[j] = silu(gt[j]) * up[j]; st_bf4(H + ro + n * 16, o); }
            }
    }
};
struct EpiF32 {
    float* C;
    DI void operator()(AccRef acc, const Unit& u, int wr, int wc, int fr, int fq) const {
        const int row0 = u.pm * 256 + wr * 64 + fr, col0 = u.pn * 256 + wc * 32 + 4 * fq;
#pragma unroll
        for (int ai = 0; ai < 2; ++ai)
#pragma unroll
            for (int m = 0; m < 4; ++m) {
                const size_t ro = (size_t)(row0 + ai * 128 + m * 16) * D + col0;
#pragma unroll
                for (int bj = 0; bj < 2; ++bj)
#pragma unroll
                    for (int n = 0; n < 2; ++n) *(f32x4*)(C + ro + bj * 128 + n * 16) = acc[ai][bj][m][n];
            }
    }
};
struct EpiPleGate {
    float* C;
    DI void operator()(AccRef acc, const Unit& u, int wr, int wc, int fr, int fq) const {
        const int row0 = u.pm * 256 + wr * 64 + fr, col0 = u.pn * 256 + wc * 32 + 4 * fq;
#pragma unroll
        for (int ai = 0; ai < 2; ++ai)
#pragma unroll
            for (int m = 0; m < 4; ++m) {
                const size_t ro = (size_t)(row0 + ai * 128 + m * 16) * D + col0;
#pragma unroll
                for (int bj = 0; bj < 2; ++bj)
#pragma unroll
                    for (int n = 0; n < 2; ++n) { const f32x4 pv = *(const f32x4*)(C + ro + bj * 128 + n * 16); const f32x4 a = acc[ai][bj][m][n]; f32x4 o; for (int j = 0; j < 4; ++j) o[j] = pv[j] * sigm(a[j]); *(f32x4*)(C + ro + bj * 128 + n * 16) = o; }
                asm volatile("" ::: "memory");
            }
    }
};

DI void prep_transpose(LAS float* tl, const float* src, bf16_t* dst, int K, int N, int mode, int H) {
    const int tid = opq(threadIdx.x); const int tn = N >> 6; const int ntiles = (K >> 6) * tn;
    for (int tile = blockIdx.x; tile < ntiles; tile += gridDim.x) {
        const int n0 = (tile % tn) * 64, k0 = (tile / tn) * 64;
        int sc0 = n0; if (mode) { const int t = n0 >> 8, r = n0 & 255; sc0 = (r < 128) ? 128 * t + r : H + 128 * t + (r - 128); }
        __syncthreads();
#pragma unroll
        for (int r = 0; r < 8; ++r) { const int k = r * 8 + (tid >> 6), n = tid & 63; tl[k * 65 + n] = src[(size_t)(k0 + k) * N + sc0 + n]; }
        __syncthreads();
#pragma unroll
        for (int r = 0; r < 4; ++r) { const int n = r * 16 + (tid >> 5), k = 2 * (tid & 31); *(unsigned*)(dst + (size_t)(n0 + n) * K + k0 + k) = pack2(tl[k * 65 + n], tl[(k + 1) * 65 + n]); }
    }
}

DI void prep_s5(LAS unsigned char* lds, const Params& P, int j, int g, bf16_t* QT, bf16_t* TPT, f32x2* LAM8) {
    LAS f32x2* powc = (LAS f32x2*)lds;
    LAS f32x2* Bb = powc + 9 * 64;
    LAS f32x2* Cc = Bb + 1024;
    LAS f32x2* coef = Cc + 1024;
    LAS float* Mm = (LAS float*)(coef + 64);
    const int tid = opq(threadIdx.x);
    const float* a_re = P.in[11] + (size_t)(j * 64 + g) * 64; const float* a_im = P.in[12] + (size_t)(j * 64 + g) * 64;
    const float* b_re = P.in[13] + (size_t)(j * 64 + g) * 1024; const float* b_im = P.in[14] + (size_t)(j * 64 + g) * 1024;
    const float* c_re = P.in[15] + (size_t)(j * 64 + g) * 1024; const float* c_im = P.in[16] + (size_t)(j * 64 + g) * 1024;
    const float* dsk = P.in[17] + (size_t)j * D + g * 16;
    __syncthreads();
    if (tid < 64) {
        const float ar = a_re[tid], ai = a_im[tid]; const float dl = __expf(P.in[18][j * 64 + g]);
        for (int t = 0; t <= 8; ++t) {
            const float mag = __expf(ar * dl * (float)t);
            const double ang = (double)ai * (double)dl * (double)t; const double nrev = rint(ang * 0.15915494309189535); const float r = (float)(ang - nrev * 6.283185307179586);
            powc[t * 64 + tid] = (f32x2){mag * __cosf(r), mag * __sinf(r)};
        }
        const f32x2 lb1 = powc[64 + tid]; const float nr = lb1.x - 1.0f, ni = lb1.y; const float den = frcp(ar * ar + ai * ai);
        coef[tid] = (f32x2){(nr * ar + ni * ai) * den, (ni * ar - nr * ai) * den};
    }
    __syncthreads();
    for (int e = tid; e < 1024; e += 512) { const int p = e >> 4; const f32x2 cf = coef[p]; const float br = b_re[e], bi = b_im[e]; Bb[e] = (f32x2){cf.x * br - cf.y * bi, cf.x * bi + cf.y * br}; Cc[e] = (f32x2){c_re[e], c_im[e]}; }
    __syncthreads();
    for (int e = tid; e < 2048; e += 512) { const int tau = e >> 8, c = (e >> 4) & 15, c2 = e & 15; float s = 0.f;
        for (int p = 0; p < 64; ++p) { const f32x2 cv = Cc[c * 64 + p], pw = powc[tau * 64 + p], bv = Bb[p * 16 + c2]; const float wr_ = cv.x * pw.x - cv.y * pw.y, wi_ = cv.x * pw.y + cv.y * pw.x; s += wr_ * bv.x - wi_ * bv.y; }
        Mm[e] = s; }
    __syncthreads();
    bf16_t* tp = TPT + (size_t)(j * 64 + g) * 32768;
    for (int e = tid; e < 32768; e += 512) { const int n = e >> 8, k = e & 255, jj = n >> 4, c = n & 15; float val;
        if (k < 128) { const int i = k >> 4, c2 = k & 15; val = (i <= jj) ? Mm[((jj - i) << 8) + (c << 4) + c2] : 0.f; if (i == jj && c == c2) val += dsk[c]; }
        else { const int kk = k - 128, p = kk >> 1; const f32x2 cv = Cc[c * 64 + p], pw = powc[(jj + 1) * 64 + p]; val = (kk & 1) ? -(cv.x * pw.y + cv.y * pw.x) : (cv.x * pw.x - cv.y * pw.y); }
        tp[e] = (bf16_t)pack2(val, 0.f); }
    bf16_t* qt = QT + (size_t)(j * 64 + g) * 16384;
    for (int e = tid; e < 16384; e += 512) { const int n = e >> 7, k = e & 127, p = n >> 1, i = k >> 4, c2 = k & 15; const f32x2 pw = powc[(7 - i) * 64 + p], bv = Bb[p * 16 + c2];
        const float val = (n & 1) ? (pw.x * bv.y + pw.y * bv.x) : (pw.x * bv.x - pw.y * bv.y); qt[e] = (bf16_t)pack2(val, 0.f); }
    if (tid < 64) LAM8[(size_t)(j * 64 + g) * 64 + tid] = powc[8 * 64 + tid];
}

DI void prep_phase(LAS unsigned char* lds, const Params& P) {
    unsigned char* ws = P.ws;
    LAS float* tl = (LAS float*)lds;
    for (int j = 0; j < 2; ++j) {
        prep_transpose(tl, P.in[7] + (size_t)j * 4194304, (bf16_t*)(ws + WS_WIN) + (size_t)j * 4194304, 1024, 4096, 0, 0);
        prep_transpose(tl, P.in[10] + (size_t)j * 1048576, (bf16_t*)(ws + WS_WOUT) + (size_t)j * 1048576, 1024, 1024, 0, 0);
        prep_transpose(tl, P.in[19] + (size_t)j * 2097152, (bf16_t*)(ws + WS_WGLU) + (size_t)j * 2097152, 1024, 2048, 1, 1024);
    }
    for (int i = 0; i < 4; ++i) {
        prep_transpose(tl, P.in[22] + (size_t)i * 5767168, (bf16_t*)(ws + WS_WUP) + (size_t)i * 5767168, 1024, 5632, 1, 2816);
        prep_transpose(tl, P.in[23] + (size_t)i * 2883584, (bf16_t*)(ws + WS_WDN) + (size_t)i * 2883584, 2816, 1024, 0, 0);
        prep_transpose(tl, P.in[27] + (size_t)i * 1048576, (bf16_t*)(ws + WS_WPG) + (size_t)i * 1048576, 1024, 1024, 0, 0);
        prep_transpose(tl, P.in[26] + (size_t)i * 262144, (bf16_t*)(ws + WS_WPP) + (size_t)i * 262144, 256, 1024, 0, 0);
    }
    const size_t gt = (size_t)blockIdx.x * 512 + opq(threadIdx.x), gs = (size_t)gridDim.x * 512;
    {
        f32x4* X4 = (f32x4*)(P.out + O_Y); u32x2* XB2 = (u32x2*)(ws + WS_XB);
        const f32x4* xp = (const f32x4*)P.in[0]; const f32x4* xs = (const f32x4*)P.in[1];
        const size_t np4 = (size_t)NPR * D / 4, nt4 = (size_t)NTOK * D / 4;
        for (size_t i = gt; i < nt4; i += gs) { const f32x4 v = (i < np4) ? xp[i] : xs[i - np4]; X4[i] = v; u32x2 w; w.x = pack2(v[0], v[1]); w.y = pack2(v[2], v[3]); XB2[i] = w; }
    }
    {
        u32x2* PB2 = (u32x2*)(ws + WS_PB); const f32x4* pp = (const f32x4*)P.in[5]; const f32x4* ps = (const f32x4*)P.in[6];
        const size_t lp4 = (size_t)NPR * PLED / 4, ls4 = (size_t)1024 * PLED / 4, lt4 = lp4 + ls4;
        for (size_t i = gt; i < 4 * lt4; i += gs) { const size_t l = i / lt4, r = i - l * lt4; const f32x4 v = (r < lp4) ? pp[l * lp4 + r] : ps[l * ls4 + (r - lp4)]; u32x2 w; w.x = pack2(v[0], v[1]); w.y = pack2(v[2], v[3]); PB2[i] = w; }
    }
    if (gt < 1024) { float* LB = (float*)(ws + WS_LB); const float b0 = P.in[8][gt], b1 = P.in[8][1024 + gt]; LB[gt] = 0.f; LB[1024 + gt] = frcp(1.0f + __expf(b0 - b1)); }
    for (int it = blockIdx.x; it < 128; it += gridDim.x) prep_s5(lds, P, it >> 6, it & 63, (bf16_t*)(ws + WS_QT), (bf16_t*)(ws + WS_TPT), (f32x2*)(ws + WS_LAM8));
}

DI void ln_phase(const float* Z, const float* w, const float* b, float* X, bf16_t* XB) {
    const int tid_ = opq(threadIdx.x); const int lane = tid_ & 63; const int wv = blockIdx.x * 8 + (tid_ >> 6), nw = gridDim.x * 8;
    f32x4 wv4[4], bv4[4];
#pragma unroll
    for (int i = 0; i < 4; ++i) { wv4[i] = ((const f32x4*)w)[lane + 64 * i]; bv4[i] = ((const f32x4*)b)[lane + 64 * i]; }
    for (int row = wv; row < NTOK; row += nw) {
        const f32x4* zr = (const f32x4*)(Z + (size_t)row * D); f32x4 v[4]; float s = 0.f;
#pragma unroll
        for (int i = 0; i < 4; ++i) { v[i] = zr[lane + 64 * i]; s += (v[i][0] + v[i][1]) + (v[i][2] + v[i][3]); }
        const float mean = wave_sum(s) * (1.0f / D); float q = 0.f;
#pragma unroll
        for (int i = 0; i < 4; ++i) { v[i] = v[i] - mean; q += (v[i][0] * v[i][0] + v[i][1] * v[i][1]) + (v[i][2] * v[i][2] + v[i][3] * v[i][3]); }
        const float rstd = rsqrtf(wave_sum(q) * (1.0f / D) + LN_EPS);
#pragma unroll
        for (int i = 0; i < 4; ++i) { const f32x4 y = v[i] * rstd * wv4[i] + bv4[i]; ((f32x4*)(X + (size_t)row * D))[lane + 64 * i] = y; u32x2 o; o.x = pack2(y[0], y[1]); o.y = pack2(y[2], y[3]); ((u32x2*)(XB + (size_t)row * D))[lane + 64 * i] = o; }
    }
}
DI void ple_norm_phase(const float* E, const float* w, float* X, bf16_t* XB) {
    const int tid_ = opq(threadIdx.x); const int lane = tid_ & 63; const int wv = blockIdx.x * 8 + (tid_ >> 6), nw = gridDim.x * 8;
    f32x4 wv4[4];
#pragma unroll
    for (int i = 0; i < 4; ++i) wv4[i] = ((const f32x4*)w)[lane + 64 * i];
    for (int row = wv; row < NTOK; row += nw) {
        const f32x4* er = (const f32x4*)(E + (size_t)row * D); f32x4 v[4]; float q = 0.f;
#pragma unroll
        for (int i = 0; i < 4; ++i) { v[i] = er[lane + 64 * i]; q += (v[i][0] * v[i][0] + v[i][1] * v[i][1]) + (v[i][2] * v[i][2] + v[i][3] * v[i][3]); }
        const float rr = rsqrtf(wave_sum(q) * (1.0f / D) + RMS_EPS);
#pragma unroll
        for (int i = 0; i < 4; ++i) { f32x4* xp = (f32x4*)(X + (size_t)row * D) + lane + 64 * i; const f32x4 y = *xp + v[i] * rr * wv4[i]; *xp = y; u32x2 o; o.x = pack2(y[0], y[1]); o.y = pack2(y[2], y[3]); ((u32x2*)(XB + (size_t)row * D))[lane + 64 * i] = o; }
    }
}
DI void hg_post_phase(const float* ORAW, const bf16_t* G, const float* gw, bf16_t* OG) {
    const int tid_ = opq(threadIdx.x); const int lane = tid_ & 63; const int wv = blockIdx.x * 8 + (tid_ >> 6), nw = gridDim.x * 8;
    f32x4 gwv[4];
#pragma unroll
    for (int i = 0; i < 4; ++i) gwv[i] = ((const f32x4*)gw)[(lane & 7) * 4 + i];
    for (int row = wv; row < NTOK; row += nw) {
        const f32x4* orow = (const f32x4*)(ORAW + (size_t)row * D) + lane * 4; f32x4 v[4]; float q = 0.f;
#pragma unroll
        for (int i = 0; i < 4; ++i) { v[i] = orow[i]; q += (v[i][0] * v[i][0] + v[i][1] * v[i][1]) + (v[i][2] * v[i][2] + v[i][3] * v[i][3]); }
        q += __shfl_xor(q, 1); q += __shfl_xor(q, 2); q += __shfl_xor(q, 4);
        const float rr = rsqrtf(q * (1.0f / 128.0f) + RMS_EPS);
        const u32x4* grow = (const u32x4*)(G + (size_t)row * D) + lane * 2; const u32x4 g0 = grow[0], g1 = grow[1];
        const unsigned gu[8] = {g0.x, g0.y, g0.z, g0.w, g1.x, g1.y, g1.z, g1.w};
        u32x4 o0, o1; unsigned ou[8];
#pragma unroll
        for (int i = 0; i < 4; ++i) { const f32x4 y = v[i] * rr * gwv[i]; ou[2 * i] = pack2(y[0] * bf_lo(gu[2 * i]), y[1] * bf_hi(gu[2 * i])); ou[2 * i + 1] = pack2(y[2] * bf_lo(gu[2 * i + 1]), y[3] * bf_hi(gu[2 * i + 1])); }
        o0.x = ou[0]; o0.y = ou[1]; o0.z = ou[2]; o0.w = ou[3]; o1.x = ou[4]; o1.y = ou[5]; o1.z = ou[6]; o1.w = ou[7];
        u32x4* op = (u32x4*)(OG + (size_t)row * D) + lane * 2; op[0] = o0; op[1] = o1;
    }
}

DI void hg_pre_phase(LAS unsigned char* lds, const bf16_t* Q, const float* LF, const bf16_t* V, bf16_t* QE, bf16_t* KDT, bf16_t* ATT, bf16_t* VF, float* DEC) {
    const int tid_ = opq(threadIdx.x); const int lane = tid_ & 63, wid = tid_ >> 6, t = lane & 31, h = lane >> 5;
    LAS bf16_t* vt = (LAS bf16_t*)(lds + wid * 17408);
    LAS bf16_t* kt = vt + 32 * 136;
    for (int item = blockIdx.x * 8 + wid; item < NITEM_HG; item += gridDim.x * 8) {
        const int ci = item >> 3, hd = item & 7;
        const int tb = (ci < 512) ? ci * 32 : NPR + (ci - 512) * 8; const int nv = (ci < 512) ? 32 : 8;
        const bool valid = t < nv; const size_t ro = (size_t)(tb + (valid ? t : 0)) * D + hd * 128;
        f32x16 attT; for (int i = 0; i < 16; ++i) attT[i] = 0.f;
#pragma unroll 1
        for (int j = 0; j < 8; ++j) {
            const int ka = 16 * j + 4 * h;
            f32x4 l0 = *(const f32x4*)(LF + ro + ka), l1 = *(const f32x4*)(LF + ro + ka + 8);
            u32x2 q0 = *(const u32x2*)(Q + ro + ka), q1 = *(const u32x2*)(Q + ro + ka + 8);
            float lf8[8] = {l0[0], l0[1], l0[2], l0[3], l1[0], l1[1], l1[2], l1[3]};
            float q8[8] = {bf_lo(q0.x), bf_hi(q0.x), bf_lo(q0.y), bf_hi(q0.y), bf_lo(q1.x), bf_hi(q1.x), bf_lo(q1.y), bf_hi(q1.y)};
            float qe[8], kd[8], qh[8], kh[8], dc[8];
#pragma unroll
            for (int i = 0; i < 8; ++i) {
                const float lf = valid ? lf8[i] : 0.f; const float qv = valid ? q8[i] : 0.f;
                float b = lf;
#pragma unroll
                for (int d = 1; d < 32; d <<= 1) { const float tmp = __shfl_up(b, d, 32); if (t >= d) b += tmp; }
                const float bl = __shfl(b, 31, 32), bm = __shfl(b, 15, 32);
                const float kk = valid ? 1.0f - __expf(lf) : 0.f;
                qe[i] = qv * __expf(b); kd[i] = kk * __expf(bl - b); qh[i] = qv * __expf(b - bm); kh[i] = kk * __expf(bm - b); dc[i] = __expf(bl);
            }
            *(bf16x8*)(QE + (size_t)item * 4096 + (j * 64 + lane) * 8) = pack8(qe[0], qe[1], qe[2], qe[3], qe[4], qe[5], qe[6], qe[7]);
            const bf16x8 qhf = pack8(qh[0], qh[1], qh[2], qh[3], qh[4], qh[5], qh[6], qh[7]);
            const bf16x8 khf = pack8(kh[0], kh[1], kh[2], kh[3], kh[4], kh[5], kh[6], kh[7]);
            attT = MFMA32(khf, qhf, attT);
            u32x2 k0, k1; k0.x = pack2(kd[0], kd[1]); k0.y = pack2(kd[2], kd[3]); k1.x = pack2(kd[4], kd[5]); k1.y = pack2(kd[6], kd[7]);
            *(LAS u32x2*)(kt + t * 136 + ka) = k0; *(LAS u32x2*)(kt + t * 136 + ka + 8) = k1;
            if (t == 0) { float* dp = DEC + (size_t)item * 128 + ((j >> 1) * 2 + h) * 16 + 8 * (j & 1); *(f32x4*)dp = (f32x4){dc[0], dc[1], dc[2], dc[3]}; *(f32x4*)(dp + 4) = (f32x4){dc[4], dc[5], dc[6], dc[7]}; }
        }
#pragma unroll
        for (int ks = 0; ks < 2; ++ks) {
            float a[8];
#pragma unroll
            for (int i = 0; i < 8; ++i) { const int s = crow(8 * ks + i, h); a[i] = (s <= t) ? attT[8 * ks + i] : 0.f; }
            *(bf16x8*)(ATT + (size_t)item * 1024 + (ks * 64 + lane) * 8) = pack8(a[0], a[1], a[2], a[3], a[4], a[5], a[6], a[7]);
        }
#pragma unroll
        for (int c8 = 0; c8 < 8; ++c8) { u32x4 vv = *(const u32x4*)(V + ro + 64 * h + 8 * c8); if (!valid) vv = (u32x4){0u, 0u, 0u, 0u}; *(LAS u32x4*)(vt + t * 136 + 64 * h + 8 * c8) = vv; }
        asm volatile("s_waitcnt lgkmcnt(0)" ::: "memory"); __builtin_amdgcn_wave_barrier();
#pragma unroll
        for (int vs = 0; vs < 4; ++vs)
#pragma unroll
            for (int ks = 0; ks < 2; ++ks) {
                unsigned short e[8]; unsigned short f[8];
#pragma unroll
                for (int i = 0; i < 8; ++i) { const int s = crow(8 * ks + i, h); e[i] = vt[s * 136 + 32 * vs + t]; f[i] = kt[s * 136 + 32 * vs + t]; }
                u32x4 pv, pk; pv.x = e[0] | ((unsigned)e[1] << 16); pv.y = e[2] | ((unsigned)e[3] << 16); pv.z = e[4] | ((unsigned)e[5] << 16); pv.w = e[6] | ((unsigned)e[7] << 16);
                pk.x = f[0] | ((unsigned)f[1] << 16); pk.y = f[2] | ((unsigned)f[3] << 16); pk.z = f[4] | ((unsigned)f[5] << 16); pk.w = f[6] | ((unsigned)f[7] << 16);
                *(u32x4*)(VF + (size_t)item * 4096 + ((vs * 2 + ks) * 64 + lane) * 8) = pv;
                *(u32x4*)(KDT + (size_t)item * 4096 + ((vs * 2 + ks) * 64 + lane) * 8) = pk;
            }
        asm volatile("s_waitcnt lgkmcnt(0)" ::: "memory"); __builtin_amdgcn_wave_barrier();
    }
}

DI void hg_scan_item(int ci0, int nch, int hd, int vs, const float* S0, float* Sout, const bf16_t* QE, const bf16_t* KDT, const bf16_t* ATT, const bf16_t* VF, const float* DEC, float* ORAW) {
    const int lane = opq(threadIdx.x) & 63, c = lane & 31, h = lane >> 5;
    f32x16 S[4];
#pragma unroll
    for (int kb = 0; kb < 4; ++kb)
#pragma unroll
        for (int r = 0; r < 16; ++r) S[kb][r] = S0 ? S0[(size_t)(32 * kb + crow(r, h)) * 128 + 32 * vs + c] : 0.f;
#pragma unroll 1
    for (int cc = 0; cc < nch; ++cc) {
        const int ci = ci0 + cc; const int item = ci * 8 + hd;
        const int tb = (ci < 512) ? ci * 32 : NPR + (ci - 512) * 8; const int nv = (ci < 512) ? 32 : 8;
        const bf16x8* qe = (const bf16x8*)(QE + (size_t)item * 4096) + lane;
        const bf16x8* kdt = (const bf16x8*)(KDT + (size_t)item * 4096) + lane;
        const bf16x8* att = (const bf16x8*)(ATT + (size_t)item * 1024) + lane;
        const bf16x8* vf = (const bf16x8*)(VF + (size_t)item * 4096) + (vs * 2) * 64 + lane;
        const f32x4* dec = (const f32x4*)(DEC + (size_t)item * 128);
        const bf16x8 a0 = att[0], a1 = att[64], v0 = vf[0], v1 = vf[64];
        f32x16 o; for (int i = 0; i < 16; ++i) o[i] = 0.f;
        o = MFMA32(a0, v0, o); o = MFMA32(a1, v1, o);
#pragma unroll
        for (int kb = 0; kb < 4; ++kb) {
            const bf16x8 q0 = qe[(2 * kb) * 64], q1 = qe[(2 * kb + 1) * 64];
            const bf16x8 s0 = pack8(S[kb][0], S[kb][1], S[kb][2], S[kb][3], S[kb][4], S[kb][5], S[kb][6], S[kb][7]);
            const bf16x8 s1 = pack8(S[kb][8], S[kb][9], S[kb][10], S[kb][11], S[kb][12], S[kb][13], S[kb][14], S[kb][15]);
            o = MFMA32(q0, s0, o); o = MFMA32(q1, s1, o);
        }
#pragma unroll
        for (int r = 0; r < 16; ++r) { const int tt = crow(r, h); if (tt < nv) ORAW[(size_t)(tb + tt) * D + hd * 128 + 32 * vs + c] = o[r]; }
#pragma unroll
        for (int kb = 0; kb < 4; ++kb) {
            const bf16x8 k0 = kdt[(kb * 2) * 64], k1 = kdt[(kb * 2 + 1) * 64];
            const f32x4 d0 = dec[(kb * 2 + h) * 4], d1 = dec[(kb * 2 + h) * 4 + 1], d2 = dec[(kb * 2 + h) * 4 + 2], d3 = dec[(kb * 2 + h) * 4 + 3];
#pragma unroll
            for (int r = 0; r < 4; ++r) { S[kb][r] *= d0[r]; S[kb][4 + r] *= d1[r]; S[kb][8 + r] *= d2[r]; S[kb][12 + r] *= d3[r]; }
            S[kb] = MFMA32(k0, v0, S[kb]); S[kb] = MFMA32(k1, v1, S[kb]);
        }
    }
#pragma unroll
    for (int kb = 0; kb < 4; ++kb)
#pragma unroll
        for (int r = 0; r < 16; ++r) Sout[(size_t)(32 * kb + crow(r, h)) * 128 + 32 * vs + c] = S[kb][r];
}
DI void hg_scan_phase(const Params& P, int j, const bf16_t* QE, const bf16_t* KDT, const bf16_t* ATT, const bf16_t* VF, const float* DEC, float* ORAW) {
    const int wid = opq(threadIdx.x) >> 6; const int G = gridDim.x; const int bx = blockIdx.x;
    int fw, nfree;
    if (G >= 64) { nfree = 256 + (G - 64) * 8; fw = (bx < 64) ? ((wid >= 4) ? bx * 4 + wid - 4 : -1) : 256 + (bx - 64) * 8 + wid; }
    else { nfree = G * 4; fw = (wid >= 4) ? bx * 4 + wid - 4 : -1; }
    if (wid < 4) {
        for (int bh = bx; bh < 64; bh += G) {
            if (G >= 64 && bx >= 64) break;
            const int b = bh >> 3, hd = bh & 7;
            hg_scan_item(b * 64, 64, hd, wid, nullptr, P.out + O_HGP + ((size_t)(j * 8 + b) * 8 + hd) * 16384, QE, KDT, ATT, VF, DEC, ORAW);
        }
    }
    if (fw >= 0) {
        for (int sid = fw; sid < 4096; sid += nfree) {
            const int vs = sid & 3, sh = sid >> 2, sb = sh >> 3, hd = sh & 7;
            const size_t so = ((size_t)(j * 128 + sb) * 8 + hd) * 16384;
            hg_scan_item(512 + sb, 1, hd, vs, P.in[2] + so, P.out + O_HGS + so, QE, KDT, ATT, VF, DEC, ORAW);
        }
    }
}

template <int MODE>
DI void s5_mm_phase(LAS unsigned char* lds, const bf16_t* XB, const bf16_t* HPREV, const bf16_t* Wt, float* E, bf16_t* YB) {
    constexpr int K = MODE ? 256 : 128, LDK = K + 8;
    LAS bf16_t* As = (LAS bf16_t*)lds; LAS bf16_t* Bs = As + 128 * LDK;
    const int tid = opq(threadIdx.x), lane = tid & 63, wid = tid >> 6, c = lane & 31, h = lane >> 5, wr2 = wid >> 1, wc2 = wid & 1;
    for (int item = blockIdx.x; item < 64 * 17; item += gridDim.x) {
        const int g = item & 63, rt = item >> 6;
        __syncthreads();
        {
            const int r = tid >> 2, q = tid & 3; const int cr = rt * 128 + r;
#pragma unroll
            for (int jj = 0; jj < 2; ++jj) { const int j = 2 * q + jj; const u32x4* src = (const u32x4*)(XB + (size_t)(cr * 8 + j) * D + g * 16); const u32x4 x0 = src[0], x1 = src[1];
                *(LAS u32x4*)(As + r * LDK + j * 16) = x0; *(LAS u32x4*)(As + r * LDK + j * 16 + 8) = x1; }
            if (MODE) { const u32x4* src = (const u32x4*)(HPREV + ((size_t)cr * 64 + g) * 128 + q * 32);
#pragma unroll
                for (int i = 0; i < 4; ++i) *(LAS u32x4*)(As + r * LDK + 128 + q * 32 + i * 8) = src[i]; }
            const u32x4* sb = (const u32x4*)(Wt + ((size_t)g * 128 + r) * K + q * (K / 4));
#pragma unroll
            for (int i = 0; i < K / 32; ++i) *(LAS u32x4*)(Bs + r * LDK + q * (K / 4) + i * 8) = sb[i];
        }
        __syncthreads();
        f32x16 acc0, acc1; for (int i = 0; i < 16; ++i) { acc0[i] = 0.f; acc1[i] = 0.f; }
#pragma unroll
        for (int ks = 0; ks < K / 16; ++ks) {
            const bf16x8 a = *(const LAS bf16x8*)(As + (32 * wr2 + c) * LDK + 16 * ks + 8 * h);
            const bf16x8 b0 = *(const LAS bf16x8*)(Bs + (64 * wc2 + c) * LDK + 16 * ks + 8 * h);
            const bf16x8 b1 = *(const LAS bf16x8*)(Bs + (64 * wc2 + 32 + c) * LDK + 16 * ks + 8 * h);
            acc0 = MFMA32(a, b0, acc0); acc1 = MFMA32(a, b1, acc1);
        }
#pragma unroll
        for (int r = 0; r < 16; ++r) {
            const int cr = rt * 128 + 32 * wr2 + crow(r, h);
            if (MODE == 0) { float* ep = E + ((size_t)cr * 64 + g) * 128 + 64 * wc2 + c; ep[0] = acc0[r]; ep[32] = acc1[r]; }
            else {
                const int n0 = 64 * wc2 + c, n1 = n0 + 32;
                YB[(size_t)(cr * 8 + (n0 >> 4)) * D + g * 16 + (n0 & 15)] = (bf16_t)pack2(gelu_tanh(acc0[r]), 0.f);
                YB[(size_t)(cr * 8 + (n1 >> 4)) * D + g * 16 + (n1 & 15)] = (bf16_t)pack2(gelu_tanh(acc1[r]), 0.f);
            }
        }
    }
}
DI void s5_scan_phase(const Params& P, int j, const float* E, bf16_t* HPREV, const f32x2* LAM8) {
    const f32x2* E2 = (const f32x2*)E; unsigned* HP = (unsigned*)HPREV; const f32x2* lam = LAM8 + (size_t)j * 4096;
    const int tid = opq(threadIdx.x);
    for (size_t id = (size_t)blockIdx.x * 512 + tid; id < (size_t)128 * 4096; id += (size_t)gridDim.x * 512) {
        const int sb = (int)(id >> 12), gp = (int)(id & 4095); const size_t ix = (size_t)(2048 + sb) * 4096 + gp;
        const float hr = P.in[3][(size_t)j * 524288 + id], hi = P.in[4][(size_t)j * 524288 + id]; const f32x2 l = lam[gp], ev = E2[ix];
        HP[ix] = pack2(hr, hi);
        P.out[O_RES + (size_t)j * 524288 + id] = l.x * hr - l.y * hi + ev.x; P.out[O_IMS + (size_t)j * 524288 + id] = l.x * hi + l.y * hr + ev.y;
    }
    if (tid < 128) {
        for (int chain = blockIdx.x * 128 + tid; chain < 32768; chain += gridDim.x * 128) {
            const int b = chain >> 12, gp = chain & 4095; const f32x2 l = lam[gp]; float hr = 0.f, hi = 0.f;
            for (int c0 = 0; c0 < 256; c0 += 8) {
                f32x2 ev[8];
#pragma unroll
                for (int i = 0; i < 8; ++i) ev[i] = E2[(size_t)(b * 256 + c0 + i) * 4096 + gp];
#pragma unroll
                for (int i = 0; i < 8; ++i) { HP[(size_t)(b * 256 + c0 + i) * 4096 + gp] = pack2(hr, hi); const float nr = l.x * hr - l.y * hi + ev[i].x, ni = l.x * hi + l.y * hr + ev[i].y; hr = nr; hi = ni; }
            }
            P.out[O_REP + (size_t)j * 32768 + chain] = hr; P.out[O_IMP + (size_t)j * 32768 + chain] = hi;
        }
    }
}


#define XB_TMO      128
#define XB_XCNT(j)  (256  + 64 * (j))
#define XB_XSUB(j)  (1280 + 64 * (j))
#define XB_XGEN(j)  (2304 + 64 * (j))
#define XB_TOP      3328
#define XB_TOPGEN   3392
#define XCD_BAR_WORDS 3456
#define XB_SPIN_CAP (1u << 22)
DI unsigned xb_ld(unsigned* p)              { return __hip_atomic_load(p, __ATOMIC_RELAXED, __HIP_MEMORY_SCOPE_AGENT); }
DI unsigned xb_add(unsigned* p, unsigned v) { return __hip_atomic_fetch_add(p, v, __ATOMIC_RELAXED, __HIP_MEMORY_SCOPE_AGENT); }
DI unsigned xb_xcc_id() { return (unsigned)__builtin_amdgcn_s_getreg((3 << 11) | 20) & 0xFu; }
#define XB_SPIN(cond, bar) do { unsigned _sp = 0; while (cond) { __builtin_amdgcn_s_sleep(1); \
    if ((++_sp & 255u) == 0u) { if (xb_ld(&(bar)[XB_TMO])) break; if (_sp > XB_SPIN_CAP) { atomicAdd(&(bar)[XB_TMO], 1u); break; } } } } while (0)
struct XcdBarrier { unsigned* bar; unsigned x; volatile LAS unsigned* st; };
DI XcdBarrier xcd_barrier_post(unsigned* bar, volatile LAS unsigned* st) {
    XcdBarrier b; b.bar = bar; b.x = xb_xcc_id(); b.st = st;
    if (threadIdx.x == 0) (void)xb_add(&bar[XB_XCNT(b.x)], 1u);
    return b;
}
DI void xcd_barrier_complete(unsigned* bar, unsigned x, unsigned& nloc, unsigned& nx) {
    const unsigned G = gridDim.x * gridDim.y * gridDim.z;
    unsigned sum, cnt, mine, sp = 0u;
    for (;;) {
        sum = 0u; cnt = 0u; mine = 0u;
#pragma unroll
        for (unsigned j = 0; j < 16; ++j) { const unsigned c = xb_ld(&bar[XB_XCNT(j)]); sum += c; cnt += (c > 0u) ? 1u : 0u; mine = (j == x) ? c : mine; }
        if (sum == G) break;
        __builtin_amdgcn_s_sleep(1);
        if ((++sp & 255u) == 0u) { if (xb_ld(&bar[XB_TMO])) break; if (sp > XB_SPIN_CAP) { atomicAdd(&bar[XB_TMO], 1u); break; } }
    }
    nloc = mine > 0u ? mine : 1u; nx = cnt > 0u ? cnt : 1u;
}
DI void xcd_barrier(const XcdBarrier& b) {
    asm volatile("s_waitcnt vmcnt(0)" ::: "memory");
    __syncthreads();
    if (threadIdx.x == 0) {
        unsigned* bar = b.bar;
        __builtin_amdgcn_s_waitcnt(0);
        unsigned nloc = b.st[0], nx = b.st[1];
        if (nloc == 0u) { xcd_barrier_complete(bar, b.x, nloc, nx); b.st[0] = nloc; b.st[1] = nx; }
        const unsigned old = xb_add(&bar[XB_XSUB(b.x)], 1u);
        const unsigned gen = old / nloc;
        if (old + 1u == (gen + 1u) * nloc) {
            __builtin_amdgcn_fence(__ATOMIC_RELEASE, "agent");
            asm volatile("s_waitcnt vmcnt(0)" ::: "memory");
            const unsigned og = xb_add(&bar[XB_TOP], 1u);
            const unsigned tg = og / nx;
            if (og + 1u == (tg + 1u) * nx) xb_add(&bar[XB_TOPGEN], 1u);
            else XB_SPIN(xb_ld(&bar[XB_TOPGEN]) == tg, bar);
            __builtin_amdgcn_fence(__ATOMIC_ACQUIRE, "agent");
            xb_add(&bar[XB_XGEN(b.x)], 1u);
            asm volatile("s_waitcnt vmcnt(0)" ::: "memory");
        } else {
            XB_SPIN(xb_ld(&bar[XB_XGEN(b.x)]) == gen, bar);
            __builtin_amdgcn_fence(__ATOMIC_ACQUIRE, "agent");
            asm volatile("s_waitcnt vmcnt(0)" ::: "memory");
        }
    }
    __syncthreads();
}

#ifndef REP_GEMM
#define REP_GEMM 1
#endif
#ifndef REP_ELT
#define REP_ELT 1
#endif
#ifndef REP_MIX
#define REP_MIX 1
#endif
#ifndef REP_SYNC
#define REP_SYNC 1
#endif
#define GSYNC() do { for (int r_ = 0; r_ < REP_SYNC; ++r_) xcd_barrier(xbar); } while (0)
#define RG for (int rg_ = 0; rg_ < REP_GEMM; ++rg_)
#define RE for (int re_ = 0; re_ < REP_ELT; ++re_)
#define RM for (int rm_ = 0; rm_ < REP_MIX; ++rm_)
__global__ void __launch_bounds__(512, 2) fwd_megakernel(Params P) {
    extern __shared__ __attribute__((aligned(16))) unsigned char lds_raw[];
    LAS unsigned char* lds = (LAS unsigned char*)lds_raw;
    cg::grid_group grid = cg::this_grid();
    unsigned char* ws = P.ws; unsigned char* U = ws + WS_U;
    float* X = P.out + O_Y; bf16_t* XB = (bf16_t*)(ws + WS_XB); float* Z = (float*)(U + U_Z);
    const int G = gridDim.x, bx = blockIdx.x;

    volatile LAS unsigned* xst = (volatile LAS unsigned*)(lds + 139264);
    if (threadIdx.x == 0) { xst[0] = 0u; xst[1] = 0u; }
    __syncthreads();
    const XcdBarrier xbar = xcd_barrier_post((unsigned*)(ws + WS_BAR), xst);
    RE prep_phase(lds, P);
    grid.sync();

#pragma unroll 1
    for (int layer_ = 0; layer_ < 4; ++layer_) {
        const int layer = opqs(layer_); const int j = layer >> 1;
        if ((layer & 1) == 0) {
            bf16_t* Qb = (bf16_t*)(U + U_Q); float* LF = (float*)(U + U_LF); bf16_t* Vb = (bf16_t*)(U + U_V); bf16_t* Gb = (bf16_t*)(U + U_G);
            bf16_t* QE = (bf16_t*)(U + U_QE); bf16_t* KDT = (bf16_t*)(U + U_KDT); bf16_t* ATT = (bf16_t*)(U + U_ATT); bf16_t* VF = (bf16_t*)(U + U_VF); float* DEC = (float*)(U + U_DEC);
            { pg8::Gemm g{XB, (const bf16_t*)(ws + WS_WIN) + (size_t)j * 4194304, NTOK, 4096, 1024}; pg8::StaticOrder S; S.init(NTOK, 4096, G, bx);
              EpiWin E{Qb, LF, Vb, Gb, (const float*)(ws + WS_LB) + j * 1024}; RG pg8::gemm_phase(lds, g, S, E); }
            GSYNC();
            RM hg_pre_phase(lds, Qb, LF, Vb, QE, KDT, ATT, VF, DEC);
            GSYNC();
            RM hg_scan_phase(P, j, QE, KDT, ATT, VF, DEC, LF  );
            GSYNC();
            RM hg_post_phase(LF, Gb, P.in[9] + j * 128, Qb  );
            GSYNC();
            { pg8::Gemm g{Qb, (const bf16_t*)(ws + WS_WOUT) + (size_t)j * 1048576, NTOK, 1024, 1024}; pg8::StaticOrder S; S.init(NTOK, 1024, G, bx);
              EpiRes E{X, Z}; RG pg8::gemm_phase(lds, g, S, E); }
            GSYNC();
        } else {
            float* Eb = (float*)(U + U_E); bf16_t* HPREV = (bf16_t*)(U + U_HPREV); bf16_t* YB = (bf16_t*)(U + U_YB);
            RM s5_mm_phase<0>(lds, XB, nullptr, (const bf16_t*)(ws + WS_QT) + (size_t)j * 1048576, Eb, nullptr);
            GSYNC();
            RM s5_scan_phase(P, j, Eb, HPREV, (const f32x2*)(ws + WS_LAM8));
            GSYNC();
            RM s5_mm_phase<1>(lds, XB, HPREV, (const bf16_t*)(ws + WS_TPT) + (size_t)j * 2097152, nullptr, YB);
            GSYNC();
            { pg8::Gemm g{YB, (const bf16_t*)(ws + WS_WGLU) + (size_t)j * 2097152, NTOK, 2048, 1024}; pg8::StaticOrder S; S.init(NTOK, 2048, G, bx);
              EpiGlu E{X, Z}; RG pg8::gemm_phase(lds, g, S, E); }
            GSYNC();
        }
        RE ln_phase(Z, P.in[20] + layer * D, P.in[21] + layer * D, X, XB);
        GSYNC();
        bf16_t* Hb = (bf16_t*)(U + U_H);
        { pg8::Gemm g{XB, (const bf16_t*)(ws + WS_WUP) + (size_t)layer * 5767168, NTOK, 5632, 1024}; pg8::StaticOrder S; S.init(NTOK, 5632, G, bx);
          EpiSwi E{Hb}; RG pg8::gemm_phase(lds, g, S, E); }
        GSYNC();
        { pg8::Gemm g{Hb, (const bf16_t*)(ws + WS_WDN) + (size_t)layer * 2883584, NTOK, 1024, DFF}; pg8::StaticOrder S; S.init(NTOK, 1024, G, bx);
          EpiRes E{X, Z}; RG pg8::gemm_phase(lds, g, S, E); }
        GSYNC();
        RE ln_phase(Z, P.in[24] + layer * D, P.in[25] + layer * D, X, XB);
        GSYNC();
        float* Pe = (float*)(U + U_P);
        RG {
        { pg8::Gemm g{(const bf16_t*)(ws + WS_PB) + (size_t)layer * NTOK * PLED, (const bf16_t*)(ws + WS_WPP) + (size_t)layer * 262144, NTOK, 1024, PLED}; pg8::StaticOrder S; S.init(NTOK, 1024, G, bx);
          EpiF32 E{Pe}; pg8::gemm_phase(lds, g, S, E); }
        { pg8::Gemm g{XB, (const bf16_t*)(ws + WS_WPG) + (size_t)layer * 1048576, NTOK, 1024, 1024}; pg8::StaticOrder S; S.init(NTOK, 1024, G, bx);
          EpiPleGate E{Pe}; pg8::gemm_phase(lds, g, S, E); }
        }
        GSYNC();
        ple_norm_phase(Pe, P.in[28] + layer * D, X, XB);
        GSYNC();
    }
}

extern "C" void kernel_launch(void* const* d_in, const int* in_sizes, int n_in, void* d_out, int out_size, void* d_ws, size_t ws_size, hipStream_t stream) {
    static int grid_blocks = 0;
    if (grid_blocks == 0) {
        int dev = 0, cus = 0, per_cu = 0;
        hipGetDevice(&dev);
        hipDeviceGetAttribute(&cus, hipDeviceAttributeMultiprocessorCount, dev);
        if (hipFuncSetAttribute((const void*)fwd_megakernel, hipFuncAttributeMaxDynamicSharedMemorySize, LDS_BYTES) != hipSuccess) { fprintf(stderr, "hipFuncSetAttribute failed\n"); grid_blocks = -1; return; }
        if (hipOccupancyMaxActiveBlocksPerMultiprocessor(&per_cu, (const void*)fwd_megakernel, 512, LDS_BYTES) != hipSuccess || per_cu < 1) { fprintf(stderr, "occupancy query failed (%d)\n", per_cu); (void)hipGetLastError(); per_cu = 1; }
        grid_blocks = cus * 1;
        if (ws_size < WS_END) { fprintf(stderr, "workspace too small: %zu < %zu\n", ws_size, (size_t)WS_END); grid_blocks = -1; return; }
    }
    if (grid_blocks < 0) return;
    if (hipMemsetAsync((unsigned char*)d_ws + WS_BAR, 0, 16384, stream) != hipSuccess) { fprintf(stderr, "memset failed\n"); return; }
    Params p{};
    for (int i = 0; i < 29; ++i) p.in[i] = (const float*)d_in[i];
    p.out = (float*)d_out; p.ws = (unsigned char*)d_ws;
    void* args[] = {&p};
    hipError_t e = hipLaunchCooperativeKernel((const void*)fwd_megakernel, dim3(grid_blocks), dim3(512), args, LDS_BYTES, stream);
    if (e != hipSuccess) fprintf(stderr, "cooperative launch failed: %s (grid %d)\n", hipGetErrorString(e), grid_blocks);
}
```

```cpp
#include <hip/hip_runtime.h>
#include <hip/hip_cooperative_groups.h>
#include <cstdio>
namespace cg = cooperative_groups;

#define LAS __attribute__((address_space(3)))
typedef unsigned short bf16_t;
typedef short bf16x8 __attribute__((ext_vector_type(8)));
typedef float f32x4 __attribute__((ext_vector_type(4)));
typedef float f32x2 __attribute__((ext_vector_type(2)));
typedef float f32x16 __attribute__((ext_vector_type(16)));
typedef unsigned u32x4 __attribute__((ext_vector_type(4)));
typedef unsigned u32x2 __attribute__((ext_vector_type(2)));
typedef __bf16 bf2_t __attribute__((ext_vector_type(2)));
#define DI __device__ __forceinline__

constexpr int D = 1024, NTOK = 17408, NPR = 16384;
constexpr int DFF = 2816, PLED = 256;
constexpr float ALPHA = 1.681792830507429f;
constexpr float QK_SCALE = 0.08838834764831845f;
constexpr float LN_EPS = 1e-5f, RMS_EPS = 1e-6f;
constexpr int LDS_BYTES = 139264 + 16;
constexpr int NITEM_HG = 5120;

constexpr size_t WS_WIN = 0;
constexpr size_t WS_WOUT = WS_WIN + 16777216;
constexpr size_t WS_WGLU = WS_WOUT + 4194304;
constexpr size_t WS_WUP = WS_WGLU + 8388608;
constexpr size_t WS_WDN = WS_WUP + 46137344;
constexpr size_t WS_WPG = WS_WDN + 23068672;
constexpr size_t WS_WPP = WS_WPG + 8388608;
constexpr size_t WS_QT = WS_WPP + 2097152;
constexpr size_t WS_TPT = WS_QT + 4194304;
constexpr size_t WS_LAM8 = WS_TPT + 8388608;
constexpr size_t WS_LB = WS_LAM8 + 65536;
constexpr size_t WS_PB = WS_LB + 8192;
constexpr size_t WS_XB = WS_PB + 35651584;
constexpr size_t WS_U = WS_XB + 35651584;
constexpr size_t U_Q = 0, U_LF = 35651584, U_V = 106954752, U_G = 142606336, U_FR = 178257920;
constexpr size_t U_QE = U_FR, U_KDT = U_QE + (size_t)NITEM_HG * 8192, U_ATT = U_KDT + (size_t)NITEM_HG * 8192, U_VF = U_ATT + (size_t)NITEM_HG * 2048, U_DEC = U_VF + (size_t)NITEM_HG * 8192;
constexpr size_t U_Z = 178257920;
constexpr size_t U_H = 0, U_P = 0, U_E = 0, U_HPREV = 71303168, U_YB = 106954752;
constexpr size_t WS_BAR = WS_U + U_DEC + (size_t)NITEM_HG * 512;
constexpr size_t WS_END = WS_BAR + 16384;

constexpr size_t O_Y = 0, O_HGP = 17825792, O_REP = 19922944, O_IMP = 19988480, O_HGS = 20054016, O_RES = 53608448, O_IMS = 54657024;

struct Params { const float* in[29]; float* out; unsigned char* ws; };

DI unsigned pack2(float lo, float hi) { f32x2 v = {lo, hi}; bf2_t b = __builtin_convertvector(v, bf2_t); return __builtin_bit_cast(unsigned, b); }
DI float bf_lo(unsigned u) { return __uint_as_float(u << 16); }
DI float bf_hi(unsigned u) { return __uint_as_float(u & 0xffff0000u); }
DI float frcp(float x) { return __builtin_amdgcn_rcpf(x); }
DI float sigm(float x) { return frcp(1.0f + __expf(-x)); }
DI float silu(float x) { return x * sigm(x); }
DI float gelu_tanh(float y) { const float u = 0.7978845608028654f * (y + 0.044715f * y * y * y); const float t = 1.0f - 2.0f * frcp(__expf(2.0f * u) + 1.0f); return 0.5f * y * (1.0f + t); }
DI float wave_sum(float v) { for (int o = 32; o >= 1; o >>= 1) v += __shfl_xor(v, o); return v; }
DI int opq(int x) { asm volatile("" : "+v"(x)); return x; }
DI int opqs(int x) { asm volatile("" : "+s"(x)); return x; }
DI int crow(int reg, int h) { return (reg & 3) + 8 * (reg >> 2) + 4 * h; }
#define MFMA32(a, b, c) __builtin_amdgcn_mfma_f32_32x32x16_bf16((a), (b), (c), 0, 0, 0)
DI bf16x8 pack8(float a0, float a1, float a2, float a3, float a4, float a5, float a6, float a7) {
    u32x4 p; p.x = pack2(a0, a1); p.y = pack2(a2, a3); p.z = pack2(a4, a5); p.w = pack2(a6, a7); return __builtin_bit_cast(bf16x8, p);
}

namespace pg8 {
constexpr int BM = 256, BK = 64, HALF = 128, HTB = HALF * BK * 2, NXCD = 8, WGM = 8;
DI int lds_byte(int r, int c) { const int st = (r >> 4) * 2 + (c >> 5), rr = r & 15, cc = c & 31, ob = rr * 64 + cc * 2; return st * 1024 + (ob ^ (((ob >> 9) & 1) << 5)); }
DI void stage_rc(int b, int& R, int& C) { const int st = b / 1024, sb = b % 1024, swz = sb ^ (((sb >> 9) & 1) << 5); R = (st >> 1) * 16 + swz / 64; C = (st & 1) * 32 + (swz % 64) / 2; }
struct Unit { int pm, pn; };
struct Gemm { const bf16_t* A; const bf16_t* Bt; int M, N, K; };
struct StaticOrder {
    int nM, nN, nwg, G, c;
    DI void init(int M, int N, int G_, int c_) { nM = M / BM; nN = N / BM; nwg = nM * nN; G = G_; c = c_; }
    DI bool next(int i, Unit& u) const {
        const long L = (long)i * G + c; if (L >= nwg) return false;
        int wgid = (int)L; { const int q = nwg / NXCD, r = nwg % NXCD, xcd = wgid % NXCD, off = wgid / NXCD; wgid = (xcd < r ? xcd * (q + 1) : r * (q + 1) + (xcd - r) * q) + off; }
        const int nig = WGM * nN, gid = wgid / nig, fm = gid * WGM, gsz = (nM - fm) < WGM ? (nM - fm) : WGM;
        u.pm = fm + ((wgid % nig) % gsz); u.pn = (wgid % nig) / gsz; return true;
    }
};

template <class Epi>
DI void gemm_phase(LAS unsigned char* lds, const Gemm g, const StaticOrder& S, const Epi& E) {
    const int tid = opq(threadIdx.x), wid = __builtin_amdgcn_readfirstlane(tid >> 6), lane = tid & 63, wr = wid >> 2, wc = wid & 3, fr = lane & 15, fq = lane >> 4;
    const int K = g.K, nt = K / BK;
    unsigned voffA[2];
#pragma unroll
    for (int i = 0; i < 2; ++i) { int R, C; stage_rc(tid * 16 + i * 8192, R, C); voffA[i] = (unsigned)(R * K + C) * 2u; }
    const size_t kstep = (size_t)(BK * 2);
    const size_t hstep = (size_t)HALF * K * 2;
    const size_t tstep = 2 * hstep;
    const unsigned ldsw = (unsigned)wid * 1024u;
    const int aoff = lds_byte(wr * 64 + fr, fq * 8), boff = lds_byte(wc * 32 + fr, fq * 8);
#define PG8_SA(b, h) (((b) * 2 + (h)) * HTB)
#define PG8_SB(b, h) ((4 + (b) * 2 + (h)) * HTB)
#define PG8_STAGE(bufoff, gbase) do { _Pragma("unroll") for (int _i = 0; _i < 2; ++_i) \
        __builtin_amdgcn_global_load_lds((const unsigned*)((const char*)(gbase) + voffA[_i]), (LAS unsigned*)(lds + (bufoff) + ldsw + _i * 8192), 16, 0, 0); } while (0)
#define PG8_LDA(dst, b, h) do { _Pragma("unroll") for (int m = 0; m < 4; ++m) _Pragma("unroll") for (int k = 0; k < 2; ++k) dst[m][k] = *(const LAS bf16x8*)(lds + PG8_SA(b, h) + aoff + m * 2048 + k * 1024); } while (0)
#define PG8_LDB(dst, b, h) do { _Pragma("unroll") for (int n = 0; n < 2; ++n) _Pragma("unroll") for (int k = 0; k < 2; ++k) dst[n][k] = *(const LAS bf16x8*)(lds + PG8_SB(b, h) + boff + n * 2048 + k * 1024); } while (0)
#define PG8_MMA(ai, bj, At, Bt) do { __builtin_amdgcn_s_setprio(1); _Pragma("unroll") for (int m = 0; m < 4; ++m) _Pragma("unroll") for (int n = 0; n < 2; ++n) _Pragma("unroll") for (int k = 0; k < 2; ++k) \
        acc[ai][bj][m][n] = __builtin_amdgcn_mfma_f32_16x16x32_bf16(Bt[n][k], At[m][k], acc[ai][bj][m][n], 0, 0, 0); __builtin_amdgcn_s_setprio(0); } while (0)
#define PG8_WAIT_V(n) asm volatile("s_waitcnt vmcnt(" #n ")" ::: "memory")
#define PG8_WAIT_L(n) asm volatile("s_waitcnt lgkmcnt(" #n ")" ::: "memory")
#define PG8_BAR __builtin_amdgcn_s_barrier()
#define PG8_SCHED __builtin_amdgcn_sched_barrier(0)
    Unit cur, nxt; int ui = 0;
    if (!S.next(0, cur)) return;
    f32x4 acc[2][2][4][2];
#pragma unroll
    for (int a = 0; a < 2; ++a)
#pragma unroll
        for (int b = 0; b < 2; ++b)
#pragma unroll
            for (int m = 0; m < 4; ++m)
#pragma unroll
                for (int n = 0; n < 2; ++n) acc[a][b][m][n] = (f32x4){0.f, 0.f, 0.f, 0.f};
    bf16x8 At[4][2], B0[2][2], B1[2][2];
    const char* cA = (const char*)g.A + (size_t)cur.pm * tstep; const char* cB = (const char*)g.Bt + (size_t)cur.pn * tstep;
    PG8_STAGE(PG8_SB(0, 0), cB); PG8_STAGE(PG8_SA(0, 0), cA); PG8_STAGE(PG8_SB(0, 1), cB + hstep); PG8_STAGE(PG8_SA(0, 1), cA + hstep);
    if (wr == 1) PG8_BAR;
    PG8_WAIT_V(4); PG8_BAR;
    PG8_STAGE(PG8_SB(1, 0), cB + kstep); PG8_STAGE(PG8_SA(1, 0), cA + kstep); PG8_STAGE(PG8_SB(1, 1), cB + hstep + kstep);
    PG8_WAIT_V(6); PG8_BAR;
    for (;;) {
        const bool has_next = S.next(ui + 1, nxt);
        const char* nA = has_next ? (const char*)g.A + (size_t)nxt.pm * tstep : cA; const char* nB = has_next ? (const char*)g.Bt + (size_t)nxt.pn * tstep : cB;
        for (int t = 0; t < nt; t += 2) {
            const bool last = (t == nt - 2);
            const char* a1 = cA + (size_t)(t + 1) * kstep;
            const char* a2 = last ? nA : cA + (size_t)(t + 2) * kstep; const char* b2 = last ? nB : cB + (size_t)(t + 2) * kstep;
            const char* a3 = a2 + kstep; const char* b3 = b2 + kstep;
            PG8_LDB(B0, 0, 0); PG8_SCHED; PG8_LDA(At, 0, 0); PG8_STAGE(PG8_SA(1, 1), a1 + hstep);
            PG8_WAIT_L(8); PG8_BAR; PG8_WAIT_L(0); PG8_MMA(0, 0, At, B0); PG8_BAR; PG8_SCHED;
            PG8_LDB(B1, 0, 1); PG8_STAGE(PG8_SB(0, 0), b2);
            PG8_BAR; PG8_WAIT_L(0); PG8_MMA(0, 1, At, B1); PG8_BAR;
            PG8_LDA(At, 0, 1); PG8_STAGE(PG8_SA(0, 0), a2);
            PG8_BAR; PG8_WAIT_L(0); PG8_MMA(1, 0, At, B0); PG8_BAR; PG8_SCHED;
            PG8_STAGE(PG8_SB(0, 1), b2 + hstep);
            PG8_WAIT_V(6); PG8_BAR; PG8_MMA(1, 1, At, B1); PG8_BAR;
            PG8_LDB(B0, 1, 0); PG8_SCHED; PG8_LDA(At, 1, 0); PG8_STAGE(PG8_SA(0, 1), a2 + hstep);
            PG8_WAIT_L(8); PG8_BAR; PG8_WAIT_L(0); PG8_MMA(0, 0, At, B0); PG8_BAR; PG8_SCHED;
            PG8_LDB(B1, 1, 1); PG8_STAGE(PG8_SB(1, 0), b3);
            PG8_BAR; PG8_WAIT_L(0); PG8_MMA(0, 1, At, B1); PG8_BAR;
            PG8_LDA(At, 1, 1); PG8_STAGE(PG8_SA(1, 0), a3);
            PG8_BAR; PG8_WAIT_L(0); PG8_MMA(1, 0, At, B0); PG8_BAR; PG8_SCHED;
            PG8_STAGE(PG8_SB(1, 1), b3 + hstep);
            PG8_WAIT_V(6); PG8_BAR; PG8_MMA(1, 1, At, B1); PG8_BAR;
        }
        E(acc, cur, wr, wc, fr, fq);
        if (!has_next) break;
#pragma unroll
        for (int a = 0; a < 2; ++a)
#pragma unroll
            for (int b = 0; b < 2; ++b)
#pragma unroll
                for (int m = 0; m < 4; ++m)
#pragma unroll
                    for (int n = 0; n < 2; ++n) acc[a][b][m][n] = (f32x4){0.f, 0.f, 0.f, 0.f};
        cur = nxt; cA = nA; cB = nB; ++ui;
    }
    PG8_WAIT_V(0);
    if (wr == 0) PG8_BAR;
    PG8_BAR;
#undef PG8_SA
#undef PG8_SB
#undef PG8_STAGE
#undef PG8_LDA
#undef PG8_LDB
#undef PG8_MMA
#undef PG8_WAIT_V
#undef PG8_WAIT_L
#undef PG8_BAR
#undef PG8_SCHED
}
}
using pg8::Unit;
typedef const f32x4 (&AccRef)[2][2][4][2];

DI void st_bf4(bf16_t* p, f32x4 v) { u32x2 w; w.x = pack2(v[0], v[1]); w.y = pack2(v[2], v[3]); *(u32x2*)p = w; }

struct EpiWin {
    bf16_t* Q; float* LF; bf16_t* V; bf16_t* G; const float* lb;
    DI void operator()(AccRef acc, const Unit& u, int wr, int wc, int fr, int fq) const {
        const int sec = u.pn >> 2;
        const int row0 = u.pm * 256 + wr * 64 + fr, col0 = (u.pn & 3) * 256 + wc * 32 + 4 * fq;
#pragma unroll
        for (int ai = 0; ai < 2; ++ai)
#pragma unroll
            for (int m = 0; m < 4; ++m) {
                const size_t ro = (size_t)(row0 + ai * 128 + m * 16) * D;
#pragma unroll
                for (int bj = 0; bj < 2; ++bj)
#pragma unroll
                    for (int n = 0; n < 2; ++n) {
                        const int col = col0 + bj * 128 + n * 16; const f32x4 a = acc[ai][bj][m][n]; f32x4 o;
                        if (sec == 0) { for (int j = 0; j < 4; ++j) o[j] = silu(a[j]) * QK_SCALE; st_bf4(Q + ro + col, o); }
                        else if (sec == 1) { const f32x4 l = *(const f32x4*)(lb + col); for (int j = 0; j < 4; ++j) o[j] = __logf(l[j] + (1.0f - l[j]) * sigm(a[j])); *(f32x4*)(LF + ro + col) = o; }
                        else if (sec == 2) { st_bf4(V + ro + col, a); }
                        else { for (int j = 0; j < 4; ++j) o[j] = silu(a[j]); st_bf4(G + ro + col, o); }
                    }
            }
    }
};
struct EpiRes {
    const float* X; float* Z;
    DI void operator()(AccRef acc, const Unit& u, int wr, int wc, int fr, int fq) const {
        const int row0 = u.pm * 256 + wr * 64 + fr, col0 = u.pn * 256 + wc * 32 + 4 * fq;
#pragma unroll
        for (int ai = 0; ai < 2; ++ai)
#pragma unroll
            for (int m = 0; m < 4; ++m) {
                const size_t ro = (size_t)(row0 + ai * 128 + m * 16) * D + col0;
#pragma unroll
                for (int bj = 0; bj < 2; ++bj)
#pragma unroll
                    for (int n = 0; n < 2; ++n) { const f32x4 x = *(const f32x4*)(X + ro + bj * 128 + n * 16); *(f32x4*)(Z + ro + bj * 128 + n * 16) = x * ALPHA + acc[ai][bj][m][n]; }
                asm volatile("" ::: "memory");
            }
    }
};
struct EpiGlu {
    const float* X; float* Z;
    DI void operator()(AccRef acc, const Unit& u, int wr, int wc, int fr, int fq) const {
        const int row0 = u.pm * 256 + wr * 64 + fr, col0 = u.pn * 128 + wc * 32 + 4 * fq;
#pragma unroll
        for (int ai = 0; ai < 2; ++ai)
#pragma unroll
            for (int m = 0; m < 4; ++m) {
                const size_t ro = (size_t)(row0 + ai * 128 + m * 16) * D + col0;
#pragma unroll
                for (int n = 0; n < 2; ++n) { const f32x4 x = *(const f32x4*)(X + ro + n * 16); const f32x4 v = acc[ai][0][m][n], gt = acc[ai][1][m][n]; f32x4 o;
                    for (int j = 0; j < 4; ++j) o[j] = x[j] * ALPHA + v[j] * sigm(gt[j]); *(f32x4*)(Z + ro + n * 16) = o; }
            }
    }
};
struct EpiSwi {
    bf16_t* H;
    DI void operator()(AccRef acc, const Unit& u, int wr, int wc, int fr, int fq) const {
        const int row0 = u.pm * 256 + wr * 64 + fr, col0 = u.pn * 128 + wc * 32 + 4 * fq;
#pragma unroll
        for (int ai = 0; ai < 2; ++ai)
#pragma unroll
            for (int m = 0; m < 4; ++m) {
                const size_t ro = (size_t)(row0 + ai * 128 + m * 16) * DFF + col0;
#pragma unroll
                for (int n = 0; n < 2; ++n) { const f32x4 gt = acc[ai][0][m][n], up = acc[ai][1][m][n]; f32x4 o; for (int j = 0; j < 4; ++j) o[j] = silu(gt[j]) * up[j]; st_bf4(H + ro + n * 16, o); }
            }
    }
};
struct EpiF32 {
    float* C;
    DI void operator()(AccRef acc, const Unit& u, int wr, int wc, int fr, int fq) const {
        const int row0 = u.pm * 256 + wr * 64 + fr, col0 = u.pn * 256 + wc * 32 + 4 * fq;
#pragma unroll
        for (int ai = 0; ai < 2; ++ai)
#pragma unroll
            for (int m = 0; m < 4; ++m) {
                const size_t ro = (size_t)(row0 + ai * 128 + m * 16) * D + col0;
#pragma unroll
                for (int bj = 0; bj < 2; ++bj)
#pragma unroll
                    for (int n = 0; n < 2; ++n) *(f32x4*)(C + ro + bj * 128 + n * 16) = acc[ai][bj][m][n];
            }
    }
};
struct EpiPleGate {
    float* C;
    DI void operator()(AccRef acc, const Unit& u, int wr, int wc, int fr, int fq) const {
        const int row0 = u.pm * 256 + wr * 64 + fr, col0 = u.pn * 256 + wc * 32 + 4 * fq;
#pragma unroll
        for (int ai = 0; ai < 2; ++ai)
#pragma unroll
            for (int m = 0; m < 4; ++m) {
                const size_t ro = (size_t)(row0 + ai * 128 + m * 16) * D + col0;
#pragma unroll
                for (int bj = 0; bj < 2; ++bj)
#pragma unroll
                    for (int n = 0; n < 2; ++n) { const f32x4 pv = *(const f32x4*)(C + ro + bj * 128 + n * 16); const f32x4 a = acc[ai][bj][m][n]; f32x4 o; for (int j = 0; j < 4; ++j) o[j] = pv[j] * sigm(a[j]); *(f32x4*)(C + ro + bj * 128 + n * 16) = o; }
                asm volatile("" ::: "memory");
            }
    }
};

DI void prep_transpose(LAS float* tl, const float* src, bf16_t* dst, int K, int N, int mode, int H) {
    const int tid = opq(threadIdx.x); const int tn = N >> 6; const int ntiles = (K >> 6) * tn;
    for (int tile = blockIdx.x; tile < ntiles; tile += gridDim.x) {
        const int n0 = (tile % tn) * 64, k0 = (tile / tn) * 64;
        int sc0 = n0; if (mode) { const int t = n0 >> 8, r = n0 & 255; sc0 = (r < 128) ? 128 * t + r : H + 128 * t + (r - 128); }
        __syncthreads();
#pragma unroll
        for (int r = 0; r < 8; ++r) { const int k = r * 8 + (tid >> 6), n = tid & 63; tl[k * 65 + n] = src[(size_t)(k0 + k) * N + sc0 + n]; }
        __syncthreads();
#pragma unroll
        for (int r = 0; r < 4; ++r) { const int n = r * 16 + (tid >> 5), k = 2 * (tid & 31); *(unsigned*)(dst + (size_t)(n0 + n) * K + k0 + k) = pack2(tl[k * 65 + n], tl[(k + 1) * 65 + n]); }
    }
}

DI void prep_s5(LAS unsigned char* lds, const Params& P, int j, int g, bf16_t* QT, bf16_t* TPT, f32x2* LAM8) {
    LAS f32x2* powc = (LAS f32x2*)lds;
    LAS f32x2* Bb = powc + 9 * 64;
    LAS f32x2* Cc = Bb + 1024;
    LAS f32x2* coef = Cc + 1024;
    LAS float* Mm = (LAS float*)(coef + 64);
    const int tid = opq(threadIdx.x);
    const float* a_re = P.in[11] + (size_t)(j * 64 + g) * 64; const float* a_im = P.in[12] + (size_t)(j * 64 + g) * 64;
    const float* b_re = P.in[13] + (size_t)(j * 64 + g) * 1024; const float* b_im = P.in[14] + (size_t)(j * 64 + g) * 1024;
    const float* c_re = P.in[15] + (size_t)(j * 64 + g) * 1024; const float* c_im = P.in[16] + (size_t)(j * 64 + g) * 1024;
    const float* dsk = P.in[17] + (size_t)j * D + g * 16;
    __syncthreads();
    if (tid < 64) {
        const float ar = a_re[tid], ai = a_im[tid]; const float dl = __expf(P.in[18][j * 64 + g]);
        for (int t = 0; t <= 8; ++t) {
            const float mag = __expf(ar * dl * (float)t);
            const double ang = (double)ai * (double)dl * (double)t; const double nrev = rint(ang * 0.15915494309189535); const float r = (float)(ang - nrev * 6.283185307179586);
            powc[t * 64 + tid] = (f32x2){mag * __cosf(r), mag * __sinf(r)};
        }
        const f32x2 lb1 = powc[64 + tid]; const float nr = lb1.x - 1.0f, ni = lb1.y; const float den = frcp(ar * ar + ai * ai);
        coef[tid] = (f32x2){(nr * ar + ni * ai) * den, (ni * ar - nr * ai) * den};
    }
    __syncthreads();
    for (int e = tid; e < 1024; e += 512) { const int p = e >> 4; const f32x2 cf = coef[p]; const float br = b_re[e], bi = b_im[e]; Bb[e] = (f32x2){cf.x * br - cf.y * bi, cf.x * bi + cf.y * br}; Cc[e] = (f32x2){c_re[e], c_im[e]}; }
    __syncthreads();
    for (int e = tid; e < 2048; e += 512) { const int tau = e >> 8, c = (e >> 4) & 15, c2 = e & 15; float s = 0.f;
        for (int p = 0; p < 64; ++p) { const f32x2 cv = Cc[c * 64 + p], pw = powc[tau * 64 + p], bv = Bb[p * 16 + c2]; const float wr_ = cv.x * pw.x - cv.y * pw.y, wi_ = cv.x * pw.y + cv.y * pw.x; s += wr_ * bv.x - wi_ * bv.y; }
        Mm[e] = s; }
    __syncthreads();
    bf16_t* tp = TPT + (size_t)(j * 64 + g) * 32768;
    for (int e = tid; e < 32768; e += 512) { const int n = e >> 8, k = e & 255, jj = n >> 4, c = n & 15; float val;
        if (k < 128) { const int i = k >> 4, c2 = k & 15; val = (i <= jj) ? Mm[((jj - i) << 8) + (c << 4) + c2] : 0.f; if (i == jj && c == c2) val += dsk[c]; }
        else { const int kk = k - 128, p = kk >> 1; const f32x2 cv = Cc[c * 64 + p], pw = powc[(jj + 1) * 64 + p]; val = (kk & 1) ? -(cv.x * pw.y + cv.y * pw.x) : (cv.x * pw.x - cv.y * pw.y); }
        tp[e] = (bf16_t)pack2(val, 0.f); }
    bf16_t* qt = QT + (size_t)(j * 64 + g) * 16384;
    for (int e = tid; e < 16384; e += 512) { const int n = e >> 7, k = e & 127, p = n >> 1, i = k >> 4, c2 = k & 15; const f32x2 pw = powc[(7 - i) * 64 + p], bv = Bb[p * 16 + c2];
        const float val = (n & 1) ? (pw.x * bv.y + pw.y * bv.x) : (pw.x * bv.x - pw.y * bv.y); qt[e] = (bf16_t)pack2(val, 0.f); }
    if (tid < 64) LAM8[(size_t)(j * 64 + g) * 64 + tid] = powc[8 * 64 + tid];
}

DI void prep_phase(LAS unsigned char* lds, const Params& P) {
    unsigned char* ws = P.ws;
    LAS float* tl = (LAS float*)lds;
    for (int j = 0; j < 2; ++j) {
        prep_transpose(tl, P.in[7] + (size_t)j * 4194304, (bf16_t*)(ws + WS_WIN) + (size_t)j * 4194304, 1024, 4096, 0, 0);
        prep_transpose(tl, P.in[10] + (size_t)j * 1048576, (bf16_t*)(ws + WS_WOUT) + (size_t)j * 1048576, 1024, 1024, 0, 0);
        prep_transpose(tl, P.in[19] + (size_t)j * 2097152, (bf16_t*)(ws + WS_WGLU) + (size_t)j * 2097152, 1024, 2048, 1, 1024);
    }
    for (int i = 0; i < 4; ++i) {
        prep_transpose(tl, P.in[22] + (size_t)i * 5767168, (bf16_t*)(ws + WS_WUP) + (size_t)i * 5767168, 1024, 5632, 1, 2816);
        prep_transpose(tl, P.in[23] + (size_t)i * 2883584, (bf16_t*)(ws + WS_WDN) + (size_t)i * 2883584, 2816, 1024, 0, 0);
        prep_transpose(tl, P.in[27] + (size_t)i * 1048576, (bf16_t*)(ws + WS_WPG) + (size_t)i * 1048576, 1024, 1024, 0, 0);
        prep_transpose(tl, P.in[26] + (size_t)i * 262144, (bf16_t*)(ws + WS_WPP) + (size_t)i * 262144, 256, 1024, 0, 0);
    }
    const size_t gt = (size_t)blockIdx.x * 512 + opq(threadIdx.x), gs = (size_t)gridDim.x * 512;
    {
        f32x4* X4 = (f32x4*)(P.out + O_Y); u32x2* XB2 = (u32x2*)(ws + WS_XB);
        const f32x4* xp = (const f32x4*)P.in[0]; const f32x4* xs = (const f32x4*)P.in[1];
        const size_t np4 = (size_t)NPR * D / 4, nt4 = (size_t)NTOK * D / 4;
        for (size_t i = gt; i < nt4; i += gs) { const f32x4 v = (i < np4) ? xp[i] : xs[i - np4]; X4[i] = v; u32x2 w; w.x = pack2(v[0], v[1]); w.y = pack2(v[2], v[3]); XB2[i] = w; }
    }
    {
        u32x2* PB2 = (u32x2*)(ws + WS_PB); const f32x4* pp = (const f32x4*)P.in[5]; const f32x4* ps = (const f32x4*)P.in[6];
        const size_t lp4 = (size_t)NPR * PLED / 4, ls4 = (size_t)1024 * PLED / 4, lt4 = lp4 + ls4;
        for (size_t i = gt; i < 4 * lt4; i += gs) { const size_t l = i / lt4, r = i - l * lt4; const f32x4 v = (r < lp4) ? pp[l * lp4 + r] : ps[l * ls4 + (r - lp4)]; u32x2 w; w.x = pack2(v[0], v[1]); w.y = pack2(v[2], v[3]); PB2[i] = w; }
    }
    if (gt < 1024) { float* LB = (float*)(ws + WS_LB); const float b0 = P.in[8][gt], b1 = P.in[8][1024 + gt]; LB[gt] = 0.f; LB[1024 + gt] = frcp(1.0f + __expf(b0 - b1)); }
    for (int it = blockIdx.x; it < 128; it += gridDim.x) prep_s5(lds, P, it >> 6, it & 63, (bf16_t*)(ws + WS_QT), (bf16_t*)(ws + WS_TPT), (f32x2*)(ws + WS_LAM8));
}

DI void ln_phase(const float* Z, const float* w, const float* b, float* X, bf16_t* XB) {
    const int tid_ = opq(threadIdx.x); const int lane = tid_ & 63; const int wv = blockIdx.x * 8 + (tid_ >> 6), nw = gridDim.x * 8;
    f32x4 wv4[4], bv4[4];
#pragma unroll
    for (int i = 0; i < 4; ++i) { wv4[i] = ((const f32x4*)w)[lane + 64 * i]; bv4[i] = ((const f32x4*)b)[lane + 64 * i]; }
    for (int row = wv; row < NTOK; row += nw) {
        const f32x4* zr = (const f32x4*)(Z + (size_t)row * D); f32x4 v[4]; float s = 0.f;
#pragma unroll
        for (int i = 0; i < 4; ++i) { v[i] = zr[lane + 64 * i]; s += (v[i][0] + v[i][1]) + (v[i][2] + v[i][3]); }
        const float mean = wave_sum(s) * (1.0f / D); float q = 0.f;
#pragma unroll
        for (int i = 0; i < 4; ++i) { v[i] = v[i] - mean; q += (v[i][0] * v[i][0] + v[i][1] * v[i][1]) + (v[i][2] * v[i][2] + v[i][3] * v[i][3]); }
        const float rstd = rsqrtf(wave_sum(q) * (1.0f / D) + LN_EPS);
#pragma unroll
        for (int i = 0; i < 4; ++i) { const f32x4 y = v[i] * rstd * wv4[i] + bv4[i]; ((f32x4*)(X + (size_t)row * D))[lane + 64 * i] = y; u32x2 o; o.x = pack2(y[0], y[1]); o.y = pack2(y[2], y[3]); ((u32x2*)(XB + (size_t)row * D))[lane + 64 * i] = o; }
    }
}
DI void ple_norm_phase(const float* E, const float* w, float* X, bf16_t* XB) {
    const int tid_ = opq(threadIdx.x); const int lane = tid_ & 63; const int wv = blockIdx.x * 8 + (tid_ >> 6), nw = gridDim.x * 8;
    f32x4 wv4[4];
#pragma unroll
    for (int i = 0; i < 4; ++i) wv4[i] = ((const f32x4*)w)[lane + 64 * i];
    for (int row = wv; row < NTOK; row += nw) {
        const f32x4* er = (const f32x4*)(E + (size_t)row * D); f32x4 v[4]; float q = 0.f;
#pragma unroll
        for (int i = 0; i < 4; ++i) { v[i] = er[lane + 64 * i]; q += (v[i][0] * v[i][0] + v[i][1] * v[i][1]) + (v[i][2] * v[i][2] + v[i][3] * v[i][3]); }
        const float rr = rsqrtf(wave_sum(q) * (1.0f / D) + RMS_EPS);
#pragma unroll
        for (int i = 0; i < 4; ++i) { f32x4* xp = (f32x4*)(X + (size_t)row * D) + lane + 64 * i; const f32x4 y = *xp + v[i] * rr * wv4[i]; *xp = y; u32x2 o; o.x = pack2(y[0], y[1]); o.y = pack2(y[2], y[3]); ((u32x2*)(XB + (size_t)row * D))[lane + 64 * i] = o; }
    }
}
DI void hg_post_phase(const float* ORAW, const bf16_t* G, const float* gw, bf16_t* OG) {
    const int tid_ = opq(threadIdx.x); const int lane = tid_ & 63; const int wv = blockIdx.x * 8 + (tid_ >> 6), nw = gridDim.x * 8;
    f32x4 gwv[4];
#pragma unroll
    for (int i = 0; i < 4; ++i) gwv[i] = ((const f32x4*)gw)[(lane & 7) * 4 + i];
    for (int row = wv; row < NTOK; row += nw) {
        const f32x4* orow = (const f32x4*)(ORAW + (size_t)row * D) + lane * 4; f32x4 v[4]; float q = 0.f;
#pragma unroll
        for (int i = 0; i < 4; ++i) { v[i] = orow[i]; q += (v[i][0] * v[i][0] + v[i][1] * v[i][1]) + (v[i][2] * v[i][2] + v[i][3] * v[i][3]); }
        q += __shfl_xor(q, 1); q += __shfl_xor(q, 2); q += __shfl_xor(q, 4);
        const float rr = rsqrtf(q * (1.0f / 128.0f) + RMS_EPS);
        const u32x4* grow = (const u32x4*)(G + (size_t)row * D) + lane * 2; const u32x4 g0 = grow[0], g1 = grow[1];
        const unsigned gu[8] = {g0.x, g0.y, g0.z, g0.w, g1.x, g1.y, g1.z, g1.w};
        u32x4 o0, o1; unsigned ou[8];
#pragma unroll
        for (int i = 0; i < 4; ++i) { const f32x4 y = v[i] * rr * gwv[i]; ou[2 * i] = pack2(y[0] * bf_lo(gu[2 * i]), y[1] * bf_hi(gu[2 * i])); ou[2 * i + 1] = pack2(y[2] * bf_lo(gu[2 * i + 1]), y[3] * bf_hi(gu[2 * i + 1])); }
        o0.x = ou[0]; o0.y = ou[1]; o0.z = ou[2]; o0.w = ou[3]; o1.x = ou[4]; o1.y = ou[5]; o1.z = ou[6]; o1.w = ou[7];
        u32x4* op = (u32x4*)(OG + (size_t)row * D) + lane * 2; op[0] = o0; op[1] = o1;
    }
}

DI void hg_pre_phase(LAS unsigned char* lds, const bf16_t* Q, const float* LF, const bf16_t* V, bf16_t* QE, bf16_t* KDT, bf16_t* ATT, bf16_t* VF, float* DEC) {
    const int tid_ = opq(threadIdx.x); const int lane = tid_ & 63, wid = tid_ >> 6, t = lane & 31, h = lane >> 5;
    LAS bf16_t* vt = (LAS bf16_t*)(lds + wid * 17408);
    LAS bf16_t* kt = vt + 32 * 136;
    for (int item = blockIdx.x * 8 + wid; item < NITEM_HG; item += gridDim.x * 8) {
        const int ci = item >> 3, hd = item & 7;
        const int tb = (ci < 512) ? ci * 32 : NPR + (ci - 512) * 8; const int nv = (ci < 512) ? 32 : 8;
        const bool valid = t < nv; const size_t ro = (size_t)(tb + (valid ? t : 0)) * D + hd * 128;
        f32x16 attT; for (int i = 0; i < 16; ++i) attT[i] = 0.f;
#pragma unroll 1
        for (int j = 0; j < 8; ++j) {
            const int ka = 16 * j + 4 * h;
            f32x4 l0 = *(const f32x4*)(LF + ro + ka), l1 = *(const f32x4*)(LF + ro + ka + 8);
            u32x2 q0 = *(const u32x2*)(Q + ro + ka), q1 = *(const u32x2*)(Q + ro + ka + 8);
            float lf8[8] = {l0[0], l0[1], l0[2], l0[3], l1[0], l1[1], l1[2], l1[3]};
            float q8[8] = {bf_lo(q0.x), bf_hi(q0.x), bf_lo(q0.y), bf_hi(q0.y), bf_lo(q1.x), bf_hi(q1.x), bf_lo(q1.y), bf_hi(q1.y)};
            float qe[8], kd[8], qh[8], kh[8], dc[8];
#pragma unroll
            for (int i = 0; i < 8; ++i) {
                const float lf = valid ? lf8[i] : 0.f; const float qv = valid ? q8[i] : 0.f;
                float b = lf;
#pragma unroll
                for (int d = 1; d < 32; d <<= 1) { const float tmp = __shfl_up(b, d, 32); if (t >= d) b += tmp; }
                const float bl = __shfl(b, 31, 32), bm = __shfl(b, 15, 32);
                const float kk = valid ? 1.0f - __expf(lf) : 0.f;
                qe[i] = qv * __expf(b); kd[i] = kk * __expf(bl - b); qh[i] = qv * __expf(b - bm); kh[i] = kk * __expf(bm - b); dc[i] = __expf(bl);
            }
            *(bf16x8*)(QE + (size_t)item * 4096 + (j * 64 + lane) * 8) = pack8(qe[0], qe[1], qe[2], qe[3], qe[4], qe[5], qe[6], qe[7]);
            const bf16x8 qhf = pack8(qh[0], qh[1], qh[2], qh[3], qh[4], qh[5], qh[6], qh[7]);
            const bf16x8 khf = pack8(kh[0], kh[1], kh[2], kh[3], kh[4], kh[5], kh[6], kh[7]);
            attT = MFMA32(khf, qhf, attT);
            u32x2 k0, k1; k0.x = pack2(kd[0], kd[1]); k0.y = pack2(kd[2], kd[3]); k1.x = pack2(kd[4], kd[5]); k1.y = pack2(kd[6], kd[7]);
            *(LAS u32x2*)(kt + t * 136 + ka) = k0; *(LAS u32x2*)(kt + t * 136 + ka + 8) = k1;
            if (t == 0) { float* dp = DEC + (size_t)item * 128 + ((j >> 1) * 2 + h) * 16 + 8 * (j & 1); *(f32x4*)dp = (f32x4){dc[0], dc[1], dc[2], dc[3]}; *(f32x4*)(dp + 4) = (f32x4){dc[4], dc[5], dc[6], dc[7]}; }
        }
#pragma unroll
        for (int ks = 0; ks < 2; ++ks) {
            float a[8];
#pragma unroll
            for (int i = 0; i < 8; ++i) { const int s = crow(8 * ks + i, h); a[i] = (s <= t) ? attT[8 * ks + i] : 0.f; }
            *(bf16x8*)(ATT + (size_t)item * 1024 + (ks * 64 + lane) * 8) = pack8(a[0], a[1], a[2], a[3], a[4], a[5], a[6], a[7]);
        }
#pragma unroll
        for (int c8 = 0; c8 < 8; ++c8) { u32x4 vv = *(const u32x4*)(V + ro + 64 * h + 8 * c8); if (!valid) vv = (u32x4){0u, 0u, 0u, 0u}; *(LAS u32x4*)(vt + t * 136 + 64 * h + 8 * c8) = vv; }
        asm volatile("s_waitcnt lgkmcnt(0)" ::: "memory"); __builtin_amdgcn_wave_barrier();
#pragma unroll
        for (int vs = 0; vs < 4; ++vs)
#pragma unroll
            for (int ks = 0; ks < 2; ++ks) {
                unsigned short e[8]; unsigned short f[8];
#pragma unroll
                for (int i = 0; i < 8; ++i) { const int s = crow(8 * ks + i, h); e[i] = vt[s * 136 + 32 * vs + t]; f[i] = kt[s * 136 + 32 * vs + t]; }
                u32x4 pv, pk; pv.x = e[0] | ((unsigned)e[1] << 16); pv.y = e[2] | ((unsigned)e[3] << 16); pv.z = e[4] | ((unsigned)e[5] << 16); pv.w = e[6] | ((unsigned)e[7] << 16);
                pk.x = f[0] | ((unsigned)f[1] << 16); pk.y = f[2] | ((unsigned)f[3] << 16); pk.z = f[4] | ((unsigned)f[5] << 16); pk.w = f[6] | ((unsigned)f[7] << 16);
                *(u32x4*)(VF + (size_t)item * 4096 + ((vs * 2 + ks) * 64 + lane) * 8) = pv;
                *(u32x4*)(KDT + (size_t)item * 4096 + ((vs * 2 + ks) * 64 + lane) * 8) = pk;
            }
        asm volatile("s_waitcnt lgkmcnt(0)" ::: "memory"); __builtin_amdgcn_wave_barrier();
    }
}

DI void hg_scan_item(int ci0, int nch, int hd, int vs, const float* S0, float* Sout, const bf16_t* QE, const bf16_t* KDT, const bf16_t* ATT, const bf16_t* VF, const float* DEC, float* ORAW) {
    const int lane = opq(threadIdx.x) & 63, c = lane & 31, h = lane >> 5;
    f32x16 S[4];
#pragma unroll
    for (int kb = 0; kb < 4; ++kb)
#pragma unroll
        for (int r = 0; r < 16; ++r) S[kb][r] = S0 ? S0[(size_t)(32 * kb + crow(r, h)) * 128 + 32 * vs + c] : 0.f;
#pragma unroll 1
    for (int cc = 0; cc < nch; ++cc) {
        const int ci = ci0 + cc; const int item = ci * 8 + hd;
        const int tb = (ci < 512) ? ci * 32 : NPR + (ci - 512) * 8; const int nv = (ci < 512) ? 32 : 8;
        const bf16x8* qe = (const bf16x8*)(QE + (size_t)item * 4096) + lane;
        const bf16x8* kdt = (const bf16x8*)(KDT + (size_t)item * 4096) + lane;
        const bf16x8* att = (const bf16x8*)(ATT + (size_t)item * 1024) + lane;
        const bf16x8* vf = (const bf16x8*)(VF + (size_t)item * 4096) + (vs * 2) * 64 + lane;
        const f32x4* dec = (const f32x4*)(DEC + (size_t)item * 128);
        const bf16x8 a0 = att[0], a1 = att[64], v0 = vf[0], v1 = vf[64];
        f32x16 o; for (int i = 0; i < 16; ++i) o[i] = 0.f;
        o = MFMA32(a0, v0, o); o = MFMA32(a1, v1, o);
#pragma unroll
        for (int kb = 0; kb < 4; ++kb) {
            const bf16x8 q0 = qe[(2 * kb) * 64], q1 = qe[(2 * kb + 1) * 64];
            const bf16x8 s0 = pack8(S[kb][0], S[kb][1], S[kb][2], S[kb][3], S[kb][4], S[kb][5], S[kb][6], S[kb][7]);
            const bf16x8 s1 = pack8(S[kb][8], S[kb][9], S[kb][10], S[kb][11], S[kb][12], S[kb][13], S[kb][14], S[kb][15]);
            o = MFMA32(q0, s0, o); o = MFMA32(q1, s1, o);
        }
#pragma unroll
        for (int r = 0; r < 16; ++r) { const int tt = crow(r, h); if (tt < nv) ORAW[(size_t)(tb + tt) * D + hd * 128 + 32 * vs + c] = o[r]; }
#pragma unroll
        for (int kb = 0; kb < 4; ++kb) {
            const bf16x8 k0 = kdt[(kb * 2) * 64], k1 = kdt[(kb * 2 + 1) * 64];
            const f32x4 d0 = dec[(kb * 2 + h) * 4], d1 = dec[(kb * 2 + h) * 4 + 1], d2 = dec[(kb * 2 + h) * 4 + 2], d3 = dec[(kb * 2 + h) * 4 + 3];
#pragma unroll
            for (int r = 0; r < 4; ++r) { S[kb][r] *= d0[r]; S[kb][4 + r] *= d1[r]; S[kb][8 + r] *= d2[r]; S[kb][12 + r] *= d3[r]; }
            S[kb] = MFMA32(k0, v0, S[kb]); S[kb] = MFMA32(k1, v1, S[kb]);
        }
    }
#pragma unroll
    for (int kb = 0; kb < 4; ++kb)
#pragma unroll
        for (int r = 0; r < 16; ++r) Sout[(size_t)(32 * kb + crow(r, h)) * 128 + 32 * vs + c] = S[kb][r];
}
DI void hg_scan_prompt_wg(LAS unsigned char* lds, int bh, float* Sout, const bf16_t* QE, const bf16_t* KDT, const bf16_t* ATT, const bf16_t* VF, const float* DEC, float* ORAW) {
    constexpr int NST = 5, DEP = 4, SLOT = 27136, NCH = 64;
    const int tid = opq(threadIdx.x), wid = __builtin_amdgcn_readfirstlane(tid >> 6), lane = tid & 63, c = lane & 31, h = lane >> 5;
    const int b = bh >> 3, hd = bh & 7, ci0 = b * 64;
    const bool producer = wid >= 4; const int pw = wid - 4, vs = wid;
#define HG_GLDS(gp, loff, sz) __builtin_amdgcn_global_load_lds((const unsigned*)(gp), (LAS unsigned*)(lds + (loff)), sz, 0, 0)
#define HG_ISSUE(chunk, slot) do { const size_t it_ = (size_t)((ci0 + (chunk)) * 8 + hd); const int sb_ = (slot) * SLOT; \
        const char* gq_ = (const char*)QE + it_ * 8192 + lane * 16; const char* gk_ = (const char*)KDT + it_ * 8192 + lane * 16; const char* gv_ = (const char*)VF + it_ * 8192 + lane * 16; \
        _Pragma("unroll") for (int i_ = 0; i_ < 2; ++i_) { const int o_ = (2 * pw + i_) * 1024; HG_GLDS(gq_ + o_, sb_ + o_, 16); HG_GLDS(gk_ + o_, sb_ + 8192 + o_, 16); HG_GLDS(gv_ + o_, sb_ + 16384 + o_, 16); } \
        if (pw < 2) HG_GLDS((const char*)ATT + it_ * 2048 + pw * 1024 + lane * 16, sb_ + 24576 + pw * 1024, 16); \
        else HG_GLDS((const char*)DEC + it_ * 512 + (pw - 2) * 256 + lane * 4, sb_ + 26624 + (pw - 2) * 256, 4); } while (0)
    f32x16 S[4];
#pragma unroll
    for (int kb = 0; kb < 4; ++kb)
#pragma unroll
        for (int r = 0; r < 16; ++r) S[kb][r] = 0.f;
    if (producer) { for (int k = 0; k < DEP; ++k) HG_ISSUE(k, k); }
#pragma unroll 1
    for (int cc = 0; cc < NCH; ++cc) {
        if (producer) asm volatile("s_waitcnt vmcnt(21)" ::: "memory");
        asm volatile("" ::: "memory"); __builtin_amdgcn_s_barrier(); asm volatile("" ::: "memory");
        if (producer) {
            const int nc = (cc + DEP < NCH) ? cc + DEP : NCH - 1; const int sl = (cc + DEP) % NST;
            HG_ISSUE(nc, sl);
        } else {
            LAS unsigned char* sl = lds + (cc % NST) * SLOT;
            const int tb = (ci0 + cc) * 32;
            const bf16x8 a0 = *(const LAS bf16x8*)(sl + 24576 + lane * 16), a1 = *(const LAS bf16x8*)(sl + 24576 + 1024 + lane * 16);
            const bf16x8 v0 = *(const LAS bf16x8*)(sl + 16384 + (vs * 2) * 1024 + lane * 16), v1 = *(const LAS bf16x8*)(sl + 16384 + (vs * 2 + 1) * 1024 + lane * 16);
            f32x16 o; for (int i = 0; i < 16; ++i) o[i] = 0.f;
            o = MFMA32(a0, v0, o); o = MFMA32(a1, v1, o);
#pragma unroll
            for (int kb = 0; kb < 4; ++kb) {
                const bf16x8 q0 = *(const LAS bf16x8*)(sl + (2 * kb) * 1024 + lane * 16), q1 = *(const LAS bf16x8*)(sl + (2 * kb + 1) * 1024 + lane * 16);
                const bf16x8 s0 = pack8(S[kb][0], S[kb][1], S[kb][2], S[kb][3], S[kb][4], S[kb][5], S[kb][6], S[kb][7]);
                const bf16x8 s1 = pack8(S[kb][8], S[kb][9], S[kb][10], S[kb][11], S[kb][12], S[kb][13], S[kb][14], S[kb][15]);
                o = MFMA32(q0, s0, o); o = MFMA32(q1, s1, o);
            }
#pragma unroll
            for (int kb = 0; kb < 4; ++kb) {
                const bf16x8 k0 = *(const LAS bf16x8*)(sl + 8192 + (kb * 2) * 1024 + lane * 16), k1 = *(const LAS bf16x8*)(sl + 8192 + (kb * 2 + 1) * 1024 + lane * 16);
                const LAS f32x4* dec = (const LAS f32x4*)(sl + 26624) + (kb * 2 + h) * 4;
                const f32x4 d0 = dec[0], d1 = dec[1], d2 = dec[2], d3 = dec[3];
#pragma unroll
                for (int r = 0; r < 4; ++r) { S[kb][r] *= d0[r]; S[kb][4 + r] *= d1[r]; S[kb][8 + r] *= d2[r]; S[kb][12 + r] *= d3[r]; }
                S[kb] = MFMA32(k0, v0, S[kb]); S[kb] = MFMA32(k1, v1, S[kb]);
            }
#pragma unroll
            for (int r = 0; r < 16; ++r) ORAW[(size_t)(tb + crow(r, h)) * D + hd * 128 + 32 * vs + c] = o[r];
            asm volatile("s_waitcnt lgkmcnt(0)" ::: "memory");
        }
    }
    if (producer) asm volatile("s_waitcnt vmcnt(0)" ::: "memory");
    else {
#pragma unroll
        for (int kb = 0; kb < 4; ++kb)
#pragma unroll
            for (int r = 0; r < 16; ++r) Sout[(size_t)(32 * kb + crow(r, h)) * 128 + 32 * vs + c] = S[kb][r];
    }
    asm volatile("" ::: "memory"); __builtin_amdgcn_s_barrier(); asm volatile("" ::: "memory");
#undef HG_GLDS
#undef HG_ISSUE
}
DI void hg_scan_phase(LAS unsigned char* lds, const Params& P, int j, const bf16_t* QE, const bf16_t* KDT, const bf16_t* ATT, const bf16_t* VF, const float* DEC, float* ORAW) {
    const int wid = opq(threadIdx.x) >> 6; const int G = gridDim.x; const int bx = blockIdx.x;
    const int npw = (G > 64) ? 64 : G;
    if (bx < npw) for (int bh = bx; bh < 64; bh += npw) hg_scan_prompt_wg(lds, bh, P.out + O_HGP + ((size_t)(j * 8 + (bh >> 3)) * 8 + (bh & 7)) * 16384, QE, KDT, ATT, VF, DEC, ORAW);
    int fw, nfree;
    if (G > 64) { nfree = (G - 64) * 8; fw = (bx >= 64) ? (bx - 64) * 8 + wid : -1; } else { nfree = G * 8; fw = bx * 8 + wid; }
    if (fw >= 0) {
        for (int sid = fw; sid < 4096; sid += nfree) {
            const int vs = sid & 3, sh = sid >> 2, sb = sh >> 3, hd = sh & 7;
            const size_t so = ((size_t)(j * 128 + sb) * 8 + hd) * 16384;
            hg_scan_item(512 + sb, 1, hd, vs, P.in[2] + so, P.out + O_HGS + so, QE, KDT, ATT, VF, DEC, ORAW);
        }
    }
}

template <int MODE>
DI void s5_mm_phase(LAS unsigned char* lds, const bf16_t* XB, const bf16_t* HPREV, const bf16_t* Wt, float* E, bf16_t* YB) {
    constexpr int K = MODE ? 256 : 128, LDK = K + 8;
    LAS bf16_t* As = (LAS bf16_t*)lds; LAS bf16_t* Bs = As + 128 * LDK;
    const int tid = opq(threadIdx.x), lane = tid & 63, wid = tid >> 6, c = lane & 31, h = lane >> 5, wr2 = wid >> 1, wc2 = wid & 1;
    for (int item = blockIdx.x; item < 64 * 17; item += gridDim.x) {
        const int g = item & 63, rt = item >> 6;
        __syncthreads();
        {
            const int r = tid >> 2, q = tid & 3; const int cr = rt * 128 + r;
#pragma unroll
            for (int jj = 0; jj < 2; ++jj) { const int j = 2 * q + jj; const u32x4* src = (const u32x4*)(XB + (size_t)(cr * 8 + j) * D + g * 16); const u32x4 x0 = src[0], x1 = src[1];
                *(LAS u32x4*)(As + r * LDK + j * 16) = x0; *(LAS u32x4*)(As + r * LDK + j * 16 + 8) = x1; }
            if (MODE) { const u32x4* src = (const u32x4*)(HPREV + ((size_t)cr * 64 + g) * 128 + q * 32);
#pragma unroll
                for (int i = 0; i < 4; ++i) *(LAS u32x4*)(As + r * LDK + 128 + q * 32 + i * 8) = src[i]; }
            const u32x4* sb = (const u32x4*)(Wt + ((size_t)g * 128 + r) * K + q * (K / 4));
#pragma unroll
            for (int i = 0; i < K / 32; ++i) *(LAS u32x4*)(Bs + r * LDK + q * (K / 4) + i * 8) = sb[i];
        }
        __syncthreads();
        f32x16 acc0, acc1; for (int i = 0; i < 16; ++i) { acc0[i] = 0.f; acc1[i] = 0.f; }
#pragma unroll
        for (int ks = 0; ks < K / 16; ++ks) {
            const bf16x8 a = *(const LAS bf16x8*)(As + (32 * wr2 + c) * LDK + 16 * ks + 8 * h);
            const bf16x8 b0 = *(const LAS bf16x8*)(Bs + (64 * wc2 + c) * LDK + 16 * ks + 8 * h);
            const bf16x8 b1 = *(const LAS bf16x8*)(Bs + (64 * wc2 + 32 + c) * LDK + 16 * ks + 8 * h);
            acc0 = MFMA32(a, b0, acc0); acc1 = MFMA32(a, b1, acc1);
        }
#pragma unroll
        for (int r = 0; r < 16; ++r) {
            const int cr = rt * 128 + 32 * wr2 + crow(r, h);
            if (MODE == 0) { float* ep = E + ((size_t)cr * 64 + g) * 128 + 64 * wc2 + c; ep[0] = acc0[r]; ep[32] = acc1[r]; }
            else {
                const int n0 = 64 * wc2 + c, n1 = n0 + 32;
                YB[(size_t)(cr * 8 + (n0 >> 4)) * D + g * 16 + (n0 & 15)] = (bf16_t)pack2(gelu_tanh(acc0[r]), 0.f);
                YB[(size_t)(cr * 8 + (n1 >> 4)) * D + g * 16 + (n1 & 15)] = (bf16_t)pack2(gelu_tanh(acc1[r]), 0.f);
            }
        }
    }
}
DI void s5_scan_phase(const Params& P, int j, const float* E, bf16_t* HPREV, const f32x2* LAM8) {
    const f32x2* E2 = (const f32x2*)E; unsigned* HP = (unsigned*)HPREV; const f32x2* lam = LAM8 + (size_t)j * 4096;
    const int tid = opq(threadIdx.x);
    for (size_t id = (size_t)blockIdx.x * 512 + tid; id < (size_t)128 * 4096; id += (size_t)gridDim.x * 512) {
        const int sb = (int)(id >> 12), gp = (int)(id & 4095); const size_t ix = (size_t)(2048 + sb) * 4096 + gp;
        const float hr = P.in[3][(size_t)j * 524288 + id], hi = P.in[4][(size_t)j * 524288 + id]; const f32x2 l = lam[gp], ev = E2[ix];
        HP[ix] = pack2(hr, hi);
        P.out[O_RES + (size_t)j * 524288 + id] = l.x * hr - l.y * hi + ev.x; P.out[O_IMS + (size_t)j * 524288 + id] = l.x * hi + l.y * hr + ev.y;
    }
    if (tid < 128) {
        for (int chain = blockIdx.x * 128 + tid; chain < 32768; chain += gridDim.x * 128) {
            const int b = chain >> 12, gp = chain & 4095; const f32x2 l = lam[gp]; float hr = 0.f, hi = 0.f;
            for (int c0 = 0; c0 < 256; c0 += 8) {
                f32x2 ev[8];
#pragma unroll
                for (int i = 0; i < 8; ++i) ev[i] = E2[(size_t)(b * 256 + c0 + i) * 4096 + gp];
#pragma unroll
                for (int i = 0; i < 8; ++i) { HP[(size_t)(b * 256 + c0 + i) * 4096 + gp] = pack2(hr, hi); const float nr = l.x * hr - l.y * hi + ev[i].x, ni = l.x * hi + l.y * hr + ev[i].y; hr = nr; hi = ni; }
            }
            P.out[O_REP + (size_t)j * 32768 + chain] = hr; P.out[O_IMP + (size_t)j * 32768 + chain] = hi;
        }
    }
}


#define XB_TMO      128
#define XB_XCNT(j)  (256  + 64 * (j))
#define XB_XSUB(j)  (1280 + 64 * (j))
#define XB_XGEN(j)  (2304 + 64 * (j))
#define XB_TOP      3328
#define XB_TOPGEN   3392
#define XCD_BAR_WORDS 3456
#define XB_SPIN_CAP (1u << 22)
DI unsigned xb_ld(unsigned* p)              { return __hip_atomic_load(p, __ATOMIC_RELAXED, __HIP_MEMORY_SCOPE_AGENT); }
DI unsigned xb_add(unsigned* p, unsigned v) { return __hip_atomic_fetch_add(p, v, __ATOMIC_RELAXED, __HIP_MEMORY_SCOPE_AGENT); }
DI unsigned xb_xcc_id() { return (unsigned)__builtin_amdgcn_s_getreg((3 << 11) | 20) & 0xFu; }
#define XB_SPIN(cond, bar) do { unsigned _sp = 0; while (cond) { __builtin_amdgcn_s_sleep(1); \
    if ((++_sp & 255u) == 0u) { if (xb_ld(&(bar)[XB_TMO])) break; if (_sp > XB_SPIN_CAP) { atomicAdd(&(bar)[XB_TMO], 1u); break; } } } } while (0)
struct XcdBarrier { unsigned* bar; unsigned x; volatile LAS unsigned* st; };
DI XcdBarrier xcd_barrier_post(unsigned* bar, volatile LAS unsigned* st) {
    XcdBarrier b; b.bar = bar; b.x = xb_xcc_id(); b.st = st;
    if (threadIdx.x == 0) (void)xb_add(&bar[XB_XCNT(b.x)], 1u);
    return b;
}
DI void xcd_barrier_complete(unsigned* bar, unsigned x, unsigned& nloc, unsigned& nx) {
    const unsigned G = gridDim.x * gridDim.y * gridDim.z;
    unsigned sum, cnt, mine, sp = 0u;
    for (;;) {
        sum = 0u; cnt = 0u; mine = 0u;
#pragma unroll
        for (unsigned j = 0; j < 16; ++j) { const unsigned c = xb_ld(&bar[XB_XCNT(j)]); sum += c; cnt += (c > 0u) ? 1u : 0u; mine = (j == x) ? c : mine; }
        if (sum == G) break;
        __builtin_amdgcn_s_sleep(1);
        if ((++sp & 255u) == 0u) { if (xb_ld(&bar[XB_TMO])) break; if (sp > XB_SPIN_CAP) { atomicAdd(&bar[XB_TMO], 1u); break; } }
    }
    nloc = mine > 0u ? mine : 1u; nx = cnt > 0u ? cnt : 1u;
}
DI void xcd_barrier(const XcdBarrier& b) {
    asm volatile("s_waitcnt vmcnt(0)" ::: "memory");
    __syncthreads();
    if (threadIdx.x == 0) {
        unsigned* bar = b.bar;
        __builtin_amdgcn_s_waitcnt(0);
        unsigned nloc = b.st[0], nx = b.st[1];
        if (nloc == 0u) { xcd_barrier_complete(bar, b.x, nloc, nx); b.st[0] = nloc; b.st[1] = nx; }
        const unsigned old = xb_add(&bar[XB_XSUB(b.x)], 1u);
        const unsigned gen = old / nloc;
        if (old + 1u == (gen + 1u) * nloc) {
            __builtin_amdgcn_fence(__ATOMIC_RELEASE, "agent");
            asm volatile("s_waitcnt vmcnt(0)" ::: "memory");
            const unsigned og = xb_add(&bar[XB_TOP], 1u);
            const unsigned tg = og / nx;
            if (og + 1u == (tg + 1u) * nx) xb_add(&bar[XB_TOPGEN], 1u);
            else XB_SPIN(xb_ld(&bar[XB_TOPGEN]) == tg, bar);
            __builtin_amdgcn_fence(__ATOMIC_ACQUIRE, "agent");
            xb_add(&bar[XB_XGEN(b.x)], 1u);
            asm volatile("s_waitcnt vmcnt(0)" ::: "memory");
        } else {
            XB_SPIN(xb_ld(&bar[XB_XGEN(b.x)]) == gen, bar);
            __builtin_amdgcn_fence(__ATOMIC_ACQUIRE, "agent");
            asm volatile("s_waitcnt vmcnt(0)" ::: "memory");
        }
    }
    __syncthreads();
}

#ifndef REP_GEMM
#define REP_GEMM 1
#endif
#ifndef REP_ELT
#define REP_ELT 1
#endif
#ifndef REP_MIX
#define REP_MIX 1
#endif
#ifndef REP_SYNC
#define REP_SYNC 1
#endif
#define GSYNC() do { for (int r_ = 0; r_ < REP_SYNC; ++r_) xcd_barrier(xbar); } while (0)
#define RG for (int rg_ = 0; rg_ < REP_GEMM; ++rg_)
#define RE for (int re_ = 0; re_ < REP_ELT; ++re_)
#define RM for (int rm_ = 0; rm_ < REP_MIX; ++rm_)
__global__ void __launch_bounds__(512, 2) fwd_megakernel(Params P) {
    extern __shared__ __attribute__((aligned(16))) unsigned char lds_raw[];
    LAS unsigned char* lds = (LAS unsigned char*)lds_raw;
    cg::grid_group grid = cg::this_grid();
    unsigned char* ws = P.ws; unsigned char* U = ws + WS_U;
    float* X = P.out + O_Y; bf16_t* XB = (bf16_t*)(ws + WS_XB); float* Z = (float*)(U + U_Z);
    const int G = gridDim.x, bx = blockIdx.x;

    volatile LAS unsigned* xst = (volatile LAS unsigned*)(lds + 139264);
    if (threadIdx.x == 0) { xst[0] = 0u; xst[1] = 0u; }
    __syncthreads();
    const XcdBarrier xbar = xcd_barrier_post((unsigned*)(ws + WS_BAR), xst);
    RE prep_phase(lds, P);
    grid.sync();

#pragma unroll 1
    for (int layer_ = 0; layer_ < 4; ++layer_) {
        const int layer = opqs(layer_); const int j = layer >> 1;
        if ((layer & 1) == 0) {
            bf16_t* Qb = (bf16_t*)(U + U_Q); float* LF = (float*)(U + U_LF); bf16_t* Vb = (bf16_t*)(U + U_V); bf16_t* Gb = (bf16_t*)(U + U_G);
            bf16_t* QE = (bf16_t*)(U + U_QE); bf16_t* KDT = (bf16_t*)(U + U_KDT); bf16_t* ATT = (bf16_t*)(U + U_ATT); bf16_t* VF = (bf16_t*)(U + U_VF); float* DEC = (float*)(U + U_DEC);
            { pg8::Gemm g{XB, (const bf16_t*)(ws + WS_WIN) + (size_t)j * 4194304, NTOK, 4096, 1024}; pg8::StaticOrder S; S.init(NTOK, 4096, G, bx);
              EpiWin E{Qb, LF, Vb, Gb, (const float*)(ws + WS_LB) + j * 1024}; RG pg8::gemm_phase(lds, g, S, E); }
            GSYNC();
            RM hg_pre_phase(lds, Qb, LF, Vb, QE, KDT, ATT, VF, DEC);
            GSYNC();
            RM hg_scan_phase(lds, P, j, QE, KDT, ATT, VF, DEC, LF  );
            GSYNC();
            RM hg_post_phase(LF, Gb, P.in[9] + j * 128, Qb  );
            GSYNC();
            { pg8::Gemm g{Qb, (const bf16_t*)(ws + WS_WOUT) + (size_t)j * 1048576, NTOK, 1024, 1024}; pg8::StaticOrder S; S.init(NTOK, 1024, G, bx);
              EpiRes E{X, Z}; RG pg8::gemm_phase(lds, g, S, E); }
            GSYNC();
        } else {
            float* Eb = (float*)(U + U_E); bf16_t* HPREV = (bf16_t*)(U + U_HPREV); bf16_t* YB = (bf16_t*)(U + U_YB);
            RM s5_mm_phase<0>(lds, XB, nullptr, (const bf16_t*)(ws + WS_QT) + (size_t)j * 1048576, Eb, nullptr);
            GSYNC();
            RM s5_scan_phase(P, j, Eb, HPREV, (const f32x2*)(ws + WS_LAM8));
            GSYNC();
            RM s5_mm_phase<1>(lds, XB, HPREV, (const bf16_t*)(ws + WS_TPT) + (size_t)j * 2097152, nullptr, YB);
            GSYNC();
            { pg8::Gemm g{YB, (const bf16_t*)(ws + WS_WGLU) + (size_t)j * 2097152, NTOK, 2048, 1024}; pg8::StaticOrder S; S.init(NTOK, 2048, G, bx);
              EpiGlu E{X, Z}; RG pg8::gemm_phase(lds, g, S, E); }
            GSYNC();
        }
        RE ln_phase(Z, P.in[20] + layer * D, P.in[21] + layer * D, X, XB);
        GSYNC();
        bf16_t* Hb = (bf16_t*)(U + U_H);
        { pg8::Gemm g{XB, (const bf16_t*)(ws + WS_WUP) + (size_t)layer * 5767168, NTOK, 5632, 1024}; pg8::StaticOrder S; S.init(NTOK, 5632, G, bx);
          EpiSwi E{Hb}; RG pg8::gemm_phase(lds, g, S, E); }
        GSYNC();
        { pg8::Gemm g{Hb, (const bf16_t*)(ws + WS_WDN) + (size_t)layer * 2883584, NTOK, 1024, DFF}; pg8::StaticOrder S; S.init(NTOK, 1024, G, bx);
          EpiRes E{X, Z}; RG pg8::gemm_phase(lds, g, S, E); }
        GSYNC();
        RE ln_phase(Z, P.in[24] + layer * D, P.in[25] + layer * D, X, XB);
        GSYNC();
        float* Pe = (float*)(U + U_P);
        RG {
        { pg8::Gemm g{(const bf16_t*)(ws + WS_PB) + (size_t)layer * NTOK * PLED, (const bf16_t*)(ws + WS_WPP) + (size_t)layer * 262144, NTOK, 1024, PLED}; pg8::StaticOrder S; S.init(NTOK, 1024, G, bx);
          EpiF32 E{Pe}; pg8::gemm_phase(lds, g, S, E); }
        { pg8::Gemm g{XB, (const bf16_t*)(ws + WS_WPG) + (size_t)layer * 1048576, NTOK, 1024, 1024}; pg8::StaticOrder S; S.init(NTOK, 1024, G, bx);
          EpiPleGate E{Pe}; pg8::gemm_phase(lds, g, S, E); }
        }
        GSYNC();
        ple_norm_phase(Pe, P.in[28] + layer * D, X, XB);
        GSYNC();
    }
}

extern "C" void kernel_launch(void* const* d_in, const int* in_sizes, int n_in, void* d_out, int out_size, void* d_ws, size_t ws_size, hipStream_t stream) {
    static int grid_blocks = 0;
    if (grid_blocks == 0) {
        int dev = 0, cus = 0, per_cu = 0;
        hipGetDevice(&dev);
        hipDeviceGetAttribute(&cus, hipDeviceAttributeMultiprocessorCount, dev);
        if (hipFuncSetAttribute((const void*)fwd_megakernel, hipFuncAttributeMaxDynamicSharedMemorySize, LDS_BYTES) != hipSuccess) { fprintf(stderr, "hipFuncSetAttribute failed\n"); grid_blocks = -1; return; }
        if (hipOccupancyMaxActiveBlocksPerMultiprocessor(&per_cu, (const void*)fwd_megakernel, 512, LDS_BYTES) != hipSuccess || per_cu < 1) { fprintf(stderr, "occupancy query failed (%d)\n", per_cu); (void)hipGetLastError(); per_cu = 1; }
        grid_blocks = cus * 1;
        if (ws_size < WS_END) { fprintf(stderr, "workspace too small: %zu < %zu\n", ws_size, (size_t)WS_END); grid_blocks = -1; return; }
    }
    if (grid_blocks < 0) return;
    if (hipMemsetAsync((unsigned char*)d_ws + WS_BAR, 0, 16384, stream) != hipSuccess) { fprintf(stderr, "memset failed\n"); return; }
    Params p{};
    for (int i = 0; i < 29; ++i) p.in[i] = (const float*)d_in[i];
    p.out = (float*)d_out; p.ws = (unsigned char*)d_ws;
    void* args[] = {&p};
    hipError_t e = hipLaunchCooperativeKernel((const void*)fwd_megakernel, dim3(grid_blocks), dim3(512), args, LDS_BYTES, stream);
    if (e != hipSuccess) fprintf(stderr, "cooperative launch failed: %s (grid %d)\n", hipGetErrorString(e), grid_blocks);
}
```
